# Optimizing an MI355X kernel written in HIP

```python
import math
import jax, jax.numpy as jnp
from jax import lax
import numpy as np


D_MODEL = 2048
BATCH = 1
SEQ = 8192
DEPTH = 4

N_MIXERS = 3
NORM_EPS = 1e-6
D_FF = 5632

SSD_EXPAND = 2
SSD_D_INNER = SSD_EXPAND * D_MODEL
SSD_HEAD_DIM = 64
SSD_N_HEADS = SSD_D_INNER // SSD_HEAD_DIM
SSD_N_GROUPS = 8
SSD_HEADS_PER_GROUP = SSD_N_HEADS // SSD_N_GROUPS
SSD_D_STATE = 128
SSD_CONV = 4
SSD_CHUNK = 128
SSD_CONV_DIM = SSD_D_INNER + 2 * SSD_N_GROUPS * SSD_D_STATE
SSD_IN_DIM = SSD_D_INNER + SSD_CONV_DIM + SSD_N_HEADS
SSD_DT_MIN = 1e-3
SSD_DT_MAX = 1e-1

GLA_N_HEADS = 4
GLA_D_K = D_MODEL // 2
GLA_D_V = D_MODEL
GLA_HEAD_K = GLA_D_K // GLA_N_HEADS
GLA_HEAD_V = GLA_D_V // GLA_N_HEADS
GLA_GATE_RANK = 16
GLA_GATE_TAU = 16.0
GLA_CHUNK = 64
GLA_IN_DIM = 2 * GLA_D_K + 2 * GLA_D_V + GLA_GATE_RANK

SGU_WIDTH = 2 * D_MODEL
SGU_N_GROUPS = 8
SGU_GROUP_DIM = SGU_WIDTH // SGU_N_GROUPS
SGU_CHUNK = 128

N_SSD = len(range(0, DEPTH, N_MIXERS))
N_GLA = len(range(1, DEPTH, N_MIXERS))
N_SGU = len(range(2, DEPTH, N_MIXERS))

kernel_name = 'hybrid_ssd_gla_sgu_macaron'


def _tril(n):
    return jnp.tril(jnp.ones((n, n), dtype=bool))


def rms_norm(x, w):
    xf = x.astype(jnp.float32)
    xf = xf * lax.rsqrt(jnp.mean(xf * xf, axis=-1, keepdims=True) + NORM_EPS)
    return (xf * w.astype(jnp.float32)).astype(x.dtype)


def grouped_rms_norm(x, w, groups):
    shp = x.shape
    xg = x.astype(jnp.float32).reshape(shp[:-1] + (groups, shp[-1] // groups))
    xg = xg * lax.rsqrt(jnp.mean(xg * xg, axis=-1, keepdims=True) + NORM_EPS)
    return (xg.reshape(shp) * w.astype(jnp.float32)).astype(x.dtype)


def swiglu_ffn(x, w_in, w_out):
    gate, up = jnp.split(x @ w_in, 2, axis=-1)
    return (jax.nn.silu(gate) * up) @ w_out


def causal_depthwise_conv(x, w, b):
    k_width = w.shape[-1]
    seq = x.shape[1]
    xp = jnp.pad(x, ((0, 0), (k_width - 1, 0), (0, 0)))
    y = b
    for k in range(k_width):
        y = y + xp[:, k:k + seq, :] * w[:, k]
    return y


def ssd_mixer(h, w_in, conv_w, conv_b, dt_bias, a_log, d_skip, norm_w, w_out):
    f32 = jnp.float32
    b, l, _ = h.shape
    Q, G, J, P, N = SSD_CHUNK, SSD_N_GROUPS, SSD_HEADS_PER_GROUP, SSD_HEAD_DIM, SSD_D_STATE
    c = l // Q
    z, xbc, dt = jnp.split(h @ w_in, [SSD_D_INNER, SSD_D_INNER + SSD_CONV_DIM], axis=-1)
    xbc = jax.nn.silu(causal_depthwise_conv(xbc, conv_w, conv_b))
    xs, bm, cm = jnp.split(xbc, [SSD_D_INNER, SSD_D_INNER + G * N], axis=-1)
    xs = xs.astype(f32).reshape(b, c, Q, G, J, P)
    bm = bm.astype(f32).reshape(b, c, Q, G, N)
    cm = cm.astype(f32).reshape(b, c, Q, G, N)
    dt = jax.nn.softplus(dt.astype(f32) + dt_bias.astype(f32)).reshape(b, c, Q, G, J)
    a = -jnp.exp(a_log.astype(f32)).reshape(G, J)
    acum = jnp.cumsum((dt * a).transpose(0, 1, 3, 4, 2), axis=-1)
    xdt = xs * dt[..., None]
    seg = acum[..., :, None] - acum[..., None, :]
    decay = jnp.exp(jnp.where(_tril(Q), seg, -jnp.inf))
    cb = jnp.einsum('bctgn,bcsgn->bcgts', cm, bm)
    scores = cb[:, :, :, None] * decay
    y_diag = jnp.einsum('bcgjts,bcsgjp->bctgjp', scores, xdt)
    decay_to_end = jnp.exp(acum[..., -1:] - acum)
    chunk_states = jnp.einsum('bcsgn,bcgjs,bcsgjp->bcgjpn', bm, decay_to_end, xdt)
    chunk_decay = jnp.exp(acum[..., -1])

    def step(state, inp):
        s_c, a_c = inp
        return state * a_c[..., None, None] + s_c, state

    _, prev = lax.scan(step, jnp.zeros((b, G, J, P, N), f32),
                       (jnp.moveaxis(chunk_states, 1, 0), jnp.moveaxis(chunk_decay, 1, 0)))
    prev = jnp.moveaxis(prev, 0, 1)
    y_off = jnp.einsum('bctgn,bcgjpn,bcgjt->bctgjp', cm, prev, jnp.exp(acum))
    y = y_diag + y_off + d_skip.astype(f32).reshape(G, J, 1) * xs
    y = y.reshape(b, l, SSD_D_INNER)
    y = grouped_rms_norm(y * jax.nn.silu(z.astype(f32)), norm_w, SSD_N_GROUPS)
    return y.astype(h.dtype) @ w_out


def gla_mixer(h, w_in, w_gate2, b_gate, norm_w, w_out):
    f32 = jnp.float32
    b, l, _ = h.shape
    H, K, V, Q = GLA_N_HEADS, GLA_HEAD_K, GLA_HEAD_V, GLA_CHUNK
    c = l // Q
    q, k, v, r, g_low = jnp.split(h @ w_in, [GLA_D_K, 2 * GLA_D_K, 2 * GLA_D_K + GLA_D_V,
                                             2 * GLA_D_K + 2 * GLA_D_V], axis=-1)
    log_a = jax.nn.log_sigmoid((g_low @ w_gate2 + b_gate).astype(f32)) / GLA_GATE_TAU

    def heads(t, d):
        return t.astype(f32).reshape(b, c, Q, H, d).transpose(0, 3, 1, 2, 4)

    q = heads(q, K) * (K ** -0.5)
    k = heads(k, K)
    v = heads(v, V)
    bcum = jnp.cumsum(heads(log_a, K), axis=3)
    ref = bcum[:, :, :, Q // 2:Q // 2 + 1, :]
    att = jnp.einsum('bhctk,bhcsk->bhcts', q * jnp.exp(bcum - ref), k * jnp.exp(ref - bcum))
    att = jnp.where(_tril(Q), att, 0.0)
    o_intra = jnp.einsum('bhcts,bhcsv->bhctv', att, v)
    q_in = q * jnp.exp(bcum)
    k_out = k * jnp.exp(bcum[..., -1:, :] - bcum)
    a_end = jnp.exp(bcum[..., -1, :])

    def step(S, inp):
        qc, kc, vc, ac = inp
        o = jnp.einsum('bhtk,bhkv->bhtv', qc, S)
        S = S * ac[..., None] + jnp.einsum('bhsk,bhsv->bhkv', kc, vc)
        return S, o

    xs = (jnp.moveaxis(q_in, 2, 0), jnp.moveaxis(k_out, 2, 0), jnp.moveaxis(v, 2, 0), jnp.moveaxis(a_end, 2, 0))
    _, o_inter = lax.scan(step, jnp.zeros((b, H, K, V), f32), xs)
    o = o_intra + jnp.moveaxis(o_inter, 0, 2)
    o = o.transpose(0, 2, 3, 1, 4).reshape(b, l, H, V)
    o = rms_norm(o, norm_w).reshape(b, l, GLA_D_V) * jax.nn.silu(r.astype(f32))
    return o.astype(h.dtype) @ w_out


def sgu_mixer(h, w_in, b_in, norm_w, w_s, b_s, w_out):
    b, l, _ = h.shape
    c = l // SGU_CHUNK
    zz = jax.nn.gelu(h @ w_in + b_in, approximate=False)
    u, v = jnp.split(zz, 2, axis=-1)
    v = rms_norm(v, norm_w).reshape(b, c, SGU_CHUNK, SGU_N_GROUPS, SGU_GROUP_DIM)
    w_causal = jnp.where(_tril(SGU_CHUNK), w_s, 0.0)
    sv = jnp.einsum('gts,bcsgd->bctgd', w_causal, v) + b_s.T[:, :, None]
    y = u * sv.reshape(b, l, SGU_WIDTH).astype(u.dtype)
    return y @ w_out


def setup_inputs(seed: int = 0) -> dict:
    key = jax.random.key(seed)
    ks = jax.random.split(key, 25)
    f32 = jnp.float32

    def nrm(k, shape, scale):
        return jax.random.normal(k, shape, f32) * scale

    def gain(k, shape):
        return 1.0 + 0.02 * jax.random.normal(k, shape, f32)

    dt = jnp.exp(jax.random.uniform(ks[8], (N_SSD, SSD_N_HEADS), f32,
                                    math.log(SSD_DT_MIN), math.log(SSD_DT_MAX)))
    return {
        'x': jax.random.normal(ks[0], (BATCH, SEQ, D_MODEL), f32),
        'ffn_norm': gain(ks[1], (DEPTH, 2, D_MODEL)),
        'ffn_w_in': nrm(ks[2], (DEPTH, 2, D_MODEL, 2 * D_FF), D_MODEL ** -0.5),
        'ffn_w_out': nrm(ks[3], (DEPTH, 2, D_FF, D_MODEL), D_FF ** -0.5),
        'mix_norm': gain(ks[4], (DEPTH, D_MODEL)),
        'ssd_w_in': nrm(ks[5], (N_SSD, D_MODEL, SSD_IN_DIM), D_MODEL ** -0.5),
        'ssd_conv_w': nrm(ks[6], (N_SSD, SSD_CONV_DIM, SSD_CONV), SSD_CONV ** -0.5),
        'ssd_conv_b': nrm(ks[7], (N_SSD, SSD_CONV_DIM), 0.02),
        'ssd_dt_bias': dt + jnp.log(-jnp.expm1(-dt)),
        'ssd_a_log': jnp.log(jax.random.uniform(ks[9], (N_SSD, SSD_N_HEADS), f32, 1.0, 16.0)),
        'ssd_d': 1.0 + 0.1 * jax.random.normal(ks[10], (N_SSD, SSD_N_HEADS), f32),
        'ssd_norm': gain(ks[11], (N_SSD, SSD_D_INNER)),
        'ssd_w_out': nrm(ks[12], (N_SSD, SSD_D_INNER, D_MODEL), SSD_D_INNER ** -0.5),
        'gla_w_in': nrm(ks[13], (N_GLA, D_MODEL, GLA_IN_DIM), D_MODEL ** -0.5),
        'gla_w_gate2': nrm(ks[14], (N_GLA, GLA_GATE_RANK, GLA_D_K), GLA_GATE_RANK ** -0.5),
        'gla_b_gate': nrm(ks[15], (N_GLA, GLA_D_K), 0.1),
        'gla_norm': gain(ks[16], (N_GLA, GLA_HEAD_V)),
        'gla_w_out': nrm(ks[17], (N_GLA, GLA_D_V, D_MODEL), GLA_D_V ** -0.5),
        'sgu_w_in': nrm(ks[18], (N_SGU, D_MODEL, 2 * SGU_WIDTH), D_MODEL ** -0.5),
        'sgu_b_in': nrm(ks[19], (N_SGU, 2 * SGU_WIDTH), 0.02),
        'sgu_norm': gain(ks[20], (N_SGU, SGU_WIDTH)),
        'sgu_w_s': nrm(ks[21], (N_SGU, SGU_N_GROUPS, SGU_CHUNK, SGU_CHUNK), SGU_CHUNK ** -0.5),
        'sgu_b_s': 1.0 + 0.1 * jax.random.normal(ks[22], (N_SGU, SGU_N_GROUPS, SGU_CHUNK), f32),
        'sgu_w_out': nrm(ks[23], (N_SGU, SGU_WIDTH, D_MODEL), SGU_WIDTH ** -0.5),
        'final_norm': gain(ks[24], (D_MODEL,)),
    }


def reference(x, ffn_norm, ffn_w_in, ffn_w_out, mix_norm,
              ssd_w_in, ssd_conv_w, ssd_conv_b, ssd_dt_bias, ssd_a_log, ssd_d, ssd_norm, ssd_w_out,
              gla_w_in, gla_w_gate2, gla_b_gate, gla_norm, gla_w_out,
              sgu_w_in, sgu_b_in, sgu_norm, sgu_w_s, sgu_b_s, sgu_w_out,
              final_norm):
    h = x
    for i in range(DEPTH):
        h = h + 0.5 * swiglu_ffn(rms_norm(h, ffn_norm[i, 0]), ffn_w_in[i, 0], ffn_w_out[i, 0])
        hn = rms_norm(h, mix_norm[i])
        kind, j = i % N_MIXERS, i // N_MIXERS
        if kind == 0:
            m = ssd_mixer(hn, ssd_w_in[j], ssd_conv_w[j], ssd_conv_b[j], ssd_dt_bias[j],
                          ssd_a_log[j], ssd_d[j], ssd_norm[j], ssd_w_out[j])
        elif kind == 1:
            m = gla_mixer(hn, gla_w_in[j], gla_w_gate2[j], gla_b_gate[j], gla_norm[j], gla_w_out[j])
        else:
            m = sgu_mixer(hn, sgu_w_in[j], sgu_b_in[j], sgu_norm[j], sgu_w_s[j], sgu_b_s[j], sgu_w_out[j])
        h = h + m
        h = h + 0.5 * swiglu_ffn(rms_norm(h, ffn_norm[i, 1]), ffn_w_in[i, 1], ffn_w_out[i, 1])
    return rms_norm(h, final_norm)
```

```cpp
#include <hip/hip_runtime.h>
#include <cstdio>
#include <cstdint>
#ifndef MK_PER_PHASE
#define MK_PER_PHASE 0
#endif
#undef MK_PER_PHASE
#define MK_PER_PHASE 1
namespace pg8 {
#define PG8_LAS __attribute__((address_space(3)))
typedef unsigned short bf16_t;
typedef short bf16x8 __attribute__((ext_vector_type(8)));
typedef float f32x4 __attribute__((ext_vector_type(4)));
typedef unsigned u32x4 __attribute__((ext_vector_type(4)));
constexpr int BM = 256, BK = 64, HALF = 128, HTB = HALF * BK * 2  , STAGE_BYTES = 8 * HTB, NXCD = 8, WGM = 8;

__host__ __device__ __forceinline__ int lds_byte(int r, int c) { const int st = (r >> 4) * 2 + (c >> 5), rr = r & 15, cc = c & 31, ob = rr * 64 + cc * 2; return st * 1024 + (ob ^ (((ob >> 9) & 1) << 5)); }
__host__ __device__ __forceinline__ void stage_rc(int b, int& R, int& C) { const int st = b / 1024, sb = b % 1024, swz = sb ^ (((sb >> 9) & 1) << 5); R = (st >> 1) * 16 + swz / 64; C = (st & 1) * 32 + (swz % 64) / 2; }
__host__ __device__ __forceinline__ int perm32(int rho) { const int n = rho >> 4, i = rho & 15; return 8 * (i >> 2) + 4 * n + (i & 3); }

struct Unit { int pm, pn; };
struct Gemm { const bf16_t* A; const bf16_t* Bt; int M, N, K; };

struct StaticOrder {
    int nM, nN, nwg, G, c;
    __host__ __device__ void init(int M, int N, int G_, int c_) { nM = M / BM; nN = N / BM; nwg = nM * nN; G = G_; c = c_; }
    __host__ __device__ bool next(int i, Unit& u) const {
        const long L = (long)i * G + c; if (L >= nwg) return false;
        int wgid = (int)L; { const int q = nwg / NXCD, r = nwg % NXCD, xcd = wgid % NXCD, off = wgid / NXCD; wgid = (xcd < r ? xcd * (q + 1) : r * (q + 1) + (xcd - r) * q) + off; }
        const int nig = WGM * nN, gid = wgid / nig, fm = gid * WGM, gsz = (nM - fm) < WGM ? (nM - fm) : WGM;
        u.pm = fm + ((wgid % nig) % gsz); u.pn = (wgid % nig) / gsz; return true;
    }
    __device__ __forceinline__ void a_ready(const Unit&) const {}
    __device__ __forceinline__ void done(const Unit&) const {}
};
__device__ __forceinline__ unsigned cvt_pk_bf16(float lo, float hi) { unsigned r; asm volatile("v_cvt_pk_bf16_f32 %0, %1, %2" : "=v"(r) : "v"(lo), "v"(hi)); return r; }
typedef float f32x2 __attribute__((ext_vector_type(2)));
__device__ __forceinline__ f32x2 gelu_pk(f32x2 v) {
    const f32x2 av = __builtin_elementwise_abs(v), d = av * 0.2316418882f + 1.0f;
    f32x2 t; t.x = __builtin_amdgcn_rcpf(d.x); t.y = __builtin_amdgcn_rcpf(d.y);
    f32x2 q = t * 0.5307027145f + (-0.7265760135f); q = q * t + 0.7107068705f; q = q * t + (-0.142248368f); q = q * t + 0.127414796f; q = q * t;
    const f32x2 s = (v * v) * (-0.72134752044f);
    f32x2 e; e.x = __builtin_amdgcn_exp2f(s.x); e.y = __builtin_amdgcn_exp2f(s.y);
    const f32x2 m = v * (q * e), r = v - m;
    f32x2 o; o.x = v.x < 0.f ? m.x : r.x; o.y = v.y < 0.f ? m.y : r.y; return o;
}
__device__ __forceinline__ float silu_f(float x) { return x / (1.0f + __expf(-x)); }
__device__ __forceinline__ u32x4 pack8(const f32x4 v0, const f32x4 v1) { u32x4 w; w.x = cvt_pk_bf16(v0[0], v0[1]); w.y = cvt_pk_bf16(v0[2], v0[3]); w.z = cvt_pk_bf16(v1[0], v1[1]); w.w = cvt_pk_bf16(v1[2], v1[3]); return w; }

struct EpiSwiGLU {
    static constexpr bool PERM = true, AFTER_DRAIN = false;
    bf16_t* O; int ldc;
    __device__ __forceinline__ void operator()(const f32x4 (&acc)[2][2][4][2], const Unit& u, int wr, int wc, int fr, int fq) const {
        const int row0 = u.pm * BM + wr * 64 + fr, col0 = u.pn * HALF + wc * 32 + 8 * fq;
#pragma unroll
        for (int ai = 0; ai < 2; ++ai)
#pragma unroll
            for (int m = 0; m < 4; ++m) { bf16_t* rowp = O + (size_t)(row0 + ai * HALF + m * 16) * ldc + col0;
                f32x4 o0, o1;
#pragma unroll
                for (int i = 0; i < 4; ++i) { o0[i] = silu_f(acc[ai][0][m][0][i]) * acc[ai][1][m][0][i]; o1[i] = silu_f(acc[ai][0][m][1][i]) * acc[ai][1][m][1][i]; }
                *(u32x4*)rowp = pack8(o0, o1); }
    }
};
struct EpiResid {
    static constexpr bool PERM = false, AFTER_DRAIN = false;
    float* H; int ldc; float scale;
    __device__ __forceinline__ void operator()(const f32x4 (&acc)[2][2][4][2], const Unit& u, int wr, int wc, int fr, int fq) const {
        const int row0 = u.pm * BM + wr * 64 + fr, col0 = u.pn * BM + wc * 32 + 4 * fq;
#pragma unroll
        for (int ai = 0; ai < 2; ++ai)
#pragma unroll
            for (int m = 0; m < 4; ++m) { float* rowp = H + (size_t)(row0 + ai * HALF + m * 16) * ldc + col0;
#pragma unroll
                for (int bj = 0; bj < 2; ++bj)
#pragma unroll
                    for (int n = 0; n < 2; ++n) { f32x4* p = (f32x4*)(rowp + bj * HALF + n * 16); *p = *p + acc[ai][bj][m][n] * scale; } }
    }
};
struct EpiBf16X {
    static constexpr bool PERM = true, AFTER_DRAIN = false;
    bf16_t* O; int ldc; const float* bias; int npn_main; float* X; int nx;
    __device__ __forceinline__ void operator()(const f32x4 (&acc)[2][2][4][2], const Unit& u, int wr, int wc, int fr, int fq) const {
        const int row0 = u.pm * BM + wr * 64 + fr;
        if (u.pn < npn_main) {
            const int col0 = u.pn * BM + wc * 32 + 8 * fq;
            f32x4 bv[2][2];
#pragma unroll
            for (int bj = 0; bj < 2; ++bj)
#pragma unroll
                for (int n = 0; n < 2; ++n) bv[bj][n] = bias ? *(const f32x4*)(bias + col0 + bj * HALF + 4 * n) : (f32x4){0.f, 0.f, 0.f, 0.f};
#pragma unroll
            for (int ai = 0; ai < 2; ++ai)
#pragma unroll
                for (int m = 0; m < 4; ++m) { bf16_t* rowp = O + (size_t)(row0 + ai * HALF + m * 16) * ldc + col0;
#pragma unroll
                    for (int bj = 0; bj < 2; ++bj) { f32x4 v0 = acc[ai][bj][m][0] + bv[bj][0], v1 = acc[ai][bj][m][1] + bv[bj][1];
                        if (bias) { f32x2 a = gelu_pk((f32x2){v0[0], v0[1]}), b = gelu_pk((f32x2){v0[2], v0[3]}), c = gelu_pk((f32x2){v1[0], v1[1]}), d = gelu_pk((f32x2){v1[2], v1[3]});
                            v0 = (f32x4){a.x, a.y, b.x, b.y}; v1 = (f32x4){c.x, c.y, d.x, d.y}; }
                        *(u32x4*)(rowp + bj * HALF) = pack8(v0, v1); } }
        } else {
            const int c0 = wc * 32 + 8 * fq;
            if (c0 < nx) {
#pragma unroll
                for (int ai = 0; ai < 2; ++ai)
#pragma unroll
                    for (int m = 0; m < 4; ++m) { float* rowp = X + (size_t)(row0 + ai * HALF + m * 16) * nx + c0;
                        *(f32x4*)rowp = acc[ai][0][m][0]; *(f32x4*)(rowp + 4) = acc[ai][0][m][1]; }
            }
        }
    }
};
template <class Epi, class Sched, bool ALIGN_EPI = false, bool SP2 = false>
__device__ __forceinline__ void gemm_phase(PG8_LAS unsigned char* lds, const Gemm g, const Sched& S, const Epi& E) {
    int tid_ = threadIdx.x; asm volatile("" : "+v"(tid_));
    const int tid = tid_, wid = __builtin_amdgcn_readfirstlane(tid >> 6), lane = tid & 63, wr = wid >> 2, wc = wid & 3, fr = lane & 15, fq = lane >> 4;
    const int K = g.K, nt = K / BK;
    unsigned voffA[2], voffB[2];
#pragma unroll
    for (int i = 0; i < 2; ++i) { int R, C; stage_rc(tid * 16 + i * 8192, R, C); const int Rb = Epi::PERM ? ((R & ~31) + perm32(R & 31)) : R;
        voffA[i] = (unsigned)(R * K + C) * 2u; voffB[i] = (unsigned)(Rb * K + C) * 2u; }
    const size_t kstep = (size_t)(BK * 2);
    const size_t hstep = (size_t)HALF * K * 2;
    const size_t tstep = 2 * hstep;
    const unsigned ldsw = (unsigned)wid * 1024u;
    const int aoff = lds_byte(wr * 64 + fr, fq * 8), boff = lds_byte(wc * 32 + fr, fq * 8);
#define PG8_SA(b, h) (((b) * 2 + (h)) * HTB)
#define PG8_SB(b, h) ((4 + (b) * 2 + (h)) * HTB)
#define PG8_STAGE(bufoff, gbase, voff) do { _Pragma("unroll") for (int _i = 0; _i < 2; ++_i) \
        __builtin_amdgcn_global_load_lds((const unsigned*)((const char*)(gbase) + (voff)[_i]), (PG8_LAS unsigned*)(lds + (bufoff) + ldsw + _i * 8192), 16, 0, 0); } while (0)
#define PG8_LDA(dst, b, h) do { _Pragma("unroll") for (int m = 0; m < 4; ++m) _Pragma("unroll") for (int k = 0; k < 2; ++k) dst[m][k] = *(const PG8_LAS bf16x8*)(lds + PG8_SA(b, h) + aoff + m * 2048 + k * 1024); } while (0)
#define PG8_LDB(dst, b, h) do { _Pragma("unroll") for (int n = 0; n < 2; ++n) _Pragma("unroll") for (int k = 0; k < 2; ++k) dst[n][k] = *(const PG8_LAS bf16x8*)(lds + PG8_SB(b, h) + boff + n * 2048 + k * 1024); } while (0)
#define PG8_MMA(ai, bj, At, Bt) do { __builtin_amdgcn_s_setprio(1); _Pragma("unroll") for (int m = 0; m < 4; ++m) _Pragma("unroll") for (int n = 0; n < 2; ++n) _Pragma("unroll") for (int k = 0; k < 2; ++k) \
        acc[ai][bj][m][n] = __builtin_amdgcn_mfma_f32_16x16x32_bf16(Bt[n][k], At[m][k], acc[ai][bj][m][n], 0, 0, 0); __builtin_amdgcn_s_setprio(0); } while (0)
#define PG8_WAIT_V(n) asm volatile("s_waitcnt vmcnt(" #n ")" ::: "memory")
#define PG8_WAIT_L(n) asm volatile("s_waitcnt lgkmcnt(" #n ")" ::: "memory")
#define PG8_BAR __builtin_amdgcn_s_barrier()
#define PG8_SCHED __builtin_amdgcn_sched_barrier(0)
    Unit cur, nxt; int ui = 0;
    if (!S.next(0, cur)) return;
    f32x4 acc[2][2][4][2];
#pragma unroll
    for (int a = 0; a < 2; ++a)
#pragma unroll
        for (int b = 0; b < 2; ++b)
#pragma unroll
            for (int m = 0; m < 4; ++m)
#pragma unroll
                for (int n = 0; n < 2; ++n) acc[a][b][m][n] = (f32x4){0.f, 0.f, 0.f, 0.f};
    bf16x8 At[4][2], B0[2][2], B1[2][2];
    const char* cA = (const char*)g.A + (size_t)cur.pm * tstep; const char* cB = (const char*)g.Bt + (size_t)cur.pn * tstep;
    S.a_ready(cur);
    if constexpr (SP2) {
        PG8_STAGE(PG8_SB(0, 0), cB, voffB); PG8_STAGE(PG8_SB(0, 1), cB + hstep, voffB); PG8_STAGE(PG8_SA(0, 0), cA, voffA); PG8_STAGE(PG8_SA(0, 1), cA + hstep, voffA);
        if (wr == 1) PG8_BAR;
        PG8_WAIT_V(2); PG8_BAR;
        PG8_STAGE(PG8_SB(1, 0), cB + kstep, voffB); PG8_STAGE(PG8_SA(1, 0), cA + kstep, voffA); PG8_STAGE(PG8_SB(1, 1), cB + hstep + kstep, voffB);
        PG8_WAIT_V(6); PG8_BAR;
    } else {
        PG8_STAGE(PG8_SB(0, 0), cB, voffB); PG8_STAGE(PG8_SA(0, 0), cA, voffA); PG8_STAGE(PG8_SB(0, 1), cB + hstep, voffB); PG8_STAGE(PG8_SA(0, 1), cA + hstep, voffA);
        if (wr == 1) PG8_BAR;
        PG8_WAIT_V(4); PG8_BAR;
        PG8_STAGE(PG8_SB(1, 0), cB + kstep, voffB); PG8_STAGE(PG8_SA(1, 0), cA + kstep, voffA); PG8_STAGE(PG8_SB(1, 1), cB + hstep + kstep, voffB);
        PG8_WAIT_V(6); PG8_BAR;
    }
    for (;;) {
        const bool has_next = S.next(ui + 1, nxt);
        const char* nA = has_next ? (const char*)g.A + (size_t)nxt.pm * tstep : cA; const char* nB = has_next ? (const char*)g.Bt + (size_t)nxt.pn * tstep : cB;
        for (int t = 0; t < nt; t += 2) {
            const bool last = (t == nt - 2);
            const char* a1 = cA + (size_t)(t + 1) * kstep;
            const char* a2 = last ? nA : cA + (size_t)(t + 2) * kstep; const char* b2 = last ? nB : cB + (size_t)(t + 2) * kstep;
            const char* a3 = a2 + kstep; const char* b3 = b2 + kstep;
            if (last && has_next) S.a_ready(nxt);
            if constexpr (SP2) {
            PG8_LDB(B0, 0, 0); PG8_LDB(B1, 0, 1); PG8_SCHED; PG8_LDA(At, 0, 0); PG8_STAGE(PG8_SA(1, 1), a1 + hstep, voffA);
            PG8_WAIT_V(8); PG8_WAIT_L(0); PG8_BAR; PG8_MMA(0, 0, At, B0); PG8_MMA(0, 1, At, B1); PG8_BAR; PG8_SCHED;
            PG8_LDA(At, 0, 1); PG8_STAGE(PG8_SB(0, 0), b2, voffB); PG8_STAGE(PG8_SB(0, 1), b2 + hstep, voffB); PG8_STAGE(PG8_SA(0, 0), a2, voffA);
            PG8_WAIT_V(8); PG8_WAIT_L(0); PG8_BAR; PG8_MMA(1, 0, At, B0); PG8_MMA(1, 1, At, B1); PG8_BAR; PG8_SCHED;
            PG8_LDB(B0, 1, 0); PG8_LDB(B1, 1, 1); PG8_SCHED; PG8_LDA(At, 1, 0); PG8_STAGE(PG8_SA(0, 1), a2 + hstep, voffA);
            PG8_WAIT_V(8); PG8_WAIT_L(0); PG8_BAR; PG8_MMA(0, 0, At, B0); PG8_MMA(0, 1, At, B1); PG8_BAR; PG8_SCHED;
            PG8_LDA(At, 1, 1); PG8_STAGE(PG8_SB(1, 0), b3, voffB); PG8_STAGE(PG8_SB(1, 1), b3 + hstep, voffB); PG8_STAGE(PG8_SA(1, 0), a3, voffA);
            PG8_WAIT_V(8); PG8_WAIT_L(0); PG8_BAR; PG8_MMA(1, 0, At, B0); PG8_MMA(1, 1, At, B1); PG8_BAR; PG8_SCHED;
            } else {
            PG8_LDB(B0, 0, 0); PG8_SCHED; PG8_LDA(At, 0, 0); PG8_STAGE(PG8_SA(1, 1), a1 + hstep, voffA);
            PG8_WAIT_L(8); PG8_BAR; PG8_WAIT_L(0); PG8_MMA(0, 0, At, B0); PG8_BAR; PG8_SCHED;
            PG8_LDB(B1, 0, 1); PG8_STAGE(PG8_SB(0, 0), b2, voffB);
            PG8_BAR; PG8_WAIT_L(0); PG8_MMA(0, 1, At, B1); PG8_BAR;
            PG8_LDA(At, 0, 1); PG8_STAGE(PG8_SA(0, 0), a2, voffA);
            PG8_BAR; PG8_WAIT_L(0); PG8_MMA(1, 0, At, B0); PG8_BAR; PG8_SCHED;
            PG8_STAGE(PG8_SB(0, 1), b2 + hstep, voffB);
            PG8_WAIT_V(6); PG8_BAR; PG8_MMA(1, 1, At, B1); PG8_BAR;
            PG8_LDB(B0, 1, 0); PG8_SCHED; PG8_LDA(At, 1, 0); PG8_STAGE(PG8_SA(0, 1), a2 + hstep, voffA);
            PG8_WAIT_L(8); PG8_BAR; PG8_WAIT_L(0); PG8_MMA(0, 0, At, B0); PG8_BAR; PG8_SCHED;
            PG8_LDB(B1, 1, 1); PG8_STAGE(PG8_SB(1, 0), b3, voffB);
            PG8_BAR; PG8_WAIT_L(0); PG8_MMA(0, 1, At, B1); PG8_BAR;
            PG8_LDA(At, 1, 1); PG8_STAGE(PG8_SA(1, 0), a3, voffA);
            PG8_BAR; PG8_WAIT_L(0); PG8_MMA(1, 0, At, B0); PG8_BAR; PG8_SCHED;
            PG8_STAGE(PG8_SB(1, 1), b3 + hstep, voffB);
            PG8_WAIT_V(6); PG8_BAR; PG8_MMA(1, 1, At, B1); PG8_BAR;
            }
        }
        if constexpr (ALIGN_EPI) { if (wr == 0) PG8_BAR; }
        if constexpr (!Epi::AFTER_DRAIN) { E(acc, cur, wr, wc, fr, fq); S.done(cur); }
        if (!has_next) break;
#pragma unroll
        for (int a = 0; a < 2; ++a)
#pragma unroll
            for (int b = 0; b < 2; ++b)
#pragma unroll
                for (int m = 0; m < 4; ++m)
#pragma unroll
                    for (int n = 0; n < 2; ++n) acc[a][b][m][n] = (f32x4){0.f, 0.f, 0.f, 0.f};
        cur = nxt; cA = nA; cB = nB; ++ui;
        if constexpr (ALIGN_EPI) { if (wr == 1) PG8_BAR; }
    }
    PG8_WAIT_V(0);
    if constexpr (!ALIGN_EPI) { if (wr == 0) PG8_BAR; }
    PG8_BAR;
    if constexpr (Epi::AFTER_DRAIN) { E.fused(acc, cur, wr, wc, fr, fq, lds, wid, lane); S.done(cur); }
#undef PG8_SA
#undef PG8_SB
#undef PG8_STAGE
#undef PG8_LDA
#undef PG8_LDB
#undef PG8_MMA
#undef PG8_WAIT_V
#undef PG8_WAIT_L
#undef PG8_BAR
#undef PG8_SCHED
}
}
constexpr int SEQ = 8192, DM = 2048, DFF = 5632, DEPTH = 4, NWAVES = 8;
constexpr float EPS = 1e-6f;
constexpr int S_DI = 4096, S_NH = 64, S_P = 64, S_G = 8, S_N = 128, S_CONVD = 6144, S_IN = 10304, S_INP = 10496, S_ZX = 10240;
constexpr int G_H = 4, G_DK = 1024, G_DV = 2048, G_HK = 256, G_HV = 512, G_R = 16, G_IN = 6160, G_INP = 6400, G_QKVR = 6144;
constexpr int U_W = 4096, U_G = 8, U_GD = 512, U_Q = 128;

constexpr size_t MiB = 1u << 20;
constexpr size_t WS_CTL = 0, CTL_ZERO_BYTES = 1 * MiB;
constexpr size_t SZ_FFN_IN = (size_t)2 * DFF * DM * 2, SZ_FFN_OUT = (size_t)DM * DFF * 2;
constexpr size_t SZ_SSD_IN = (size_t)S_INP * DM * 2, SZ_SSD_OUT = (size_t)DM * S_DI * 2;
constexpr size_t WS_W_FFN_IN = 1 * MiB;
constexpr size_t WS_W_FFN_OUT = WS_W_FFN_IN + 8 * SZ_FFN_IN;
constexpr size_t WS_W_SSD_IN = WS_W_FFN_OUT + 8 * SZ_FFN_OUT;
constexpr size_t WS_W_SSD_OUT = WS_W_SSD_IN + 2 * SZ_SSD_IN;
constexpr size_t WS_W_GLA_IN = WS_W_SSD_OUT + 2 * SZ_SSD_OUT;
constexpr size_t WS_W_GLA_OUT = WS_W_GLA_IN + (size_t)G_INP * DM * 2;
constexpr size_t WS_W_SGU_IN = WS_W_GLA_OUT + (size_t)DM * G_DV * 2;
constexpr size_t WS_W_SGU_OUT = WS_W_SGU_IN + (size_t)2 * U_W * DM * 2;
constexpr size_t WS_W_END = WS_W_SGU_OUT + (size_t)DM * U_W * 2;
constexpr size_t WS_H = (WS_W_END + MiB - 1) / MiB * MiB;
constexpr size_t WS_HN = WS_H + (size_t)SEQ * DM * 4;
constexpr size_t WS_BIG = WS_HN + (size_t)SEQ * DM * 2;
constexpr size_t WS_MIX = WS_BIG + (size_t)SEQ * S_ZX * 2;
constexpr size_t WS_SCR = WS_MIX + (size_t)SEQ * 4096 * 2;
constexpr size_t WS_SCR_BYTES = 512 * MiB;
constexpr size_t WS_END = WS_SCR + WS_SCR_BYTES;
static_assert(WS_H % 256 == 0 && WS_W_SSD_IN % 256 == 0 && WS_W_GLA_IN % 256 == 0, "alignment");
constexpr size_t SC_XC = 0;
constexpr size_t SC_DTR = SC_XC + (size_t)SEQ * S_CONVD * 2;
constexpr size_t SC_DT = SC_DTR + (size_t)SEQ * 64 * 4;
constexpr size_t SC_YG = SC_DT + (size_t)SEQ * 64 * 4;
constexpr size_t SC_SSD_END = SC_YG + (size_t)SEQ * 4096 * 4;
constexpr size_t SC_GL = 0;
constexpr size_t SC_AG = SC_GL + (size_t)SEQ * 16 * 4;
constexpr size_t SC_OG = SC_AG + (size_t)SEQ * 1024 * 4;
constexpr size_t SC_GLA_END = SC_OG + (size_t)SEQ * 2048 * 4;
constexpr size_t SC_RS = 0;
static_assert(SC_SSD_END <= WS_SCR_BYTES && SC_GLA_END <= WS_SCR_BYTES, "scratch map");
constexpr int CW_BAR = 4096;

constexpr int RING_OFF = 0, RING_BYTES = 131072;
constexpr int LDSCTL_OFF = RING_BYTES, MISC_OFF = LDSCTL_OFF + 320;
constexpr int LDS_BYTES = 147456;

#define GAS __attribute__((address_space(1)))
#define LAS __attribute__((address_space(3)))
typedef unsigned short bf16;
typedef unsigned v4u __attribute__((ext_vector_type(4)));
typedef unsigned v2u __attribute__((ext_vector_type(2)));
typedef float f32x4 __attribute__((ext_vector_type(4)));
#define LDS_WAIT() asm volatile("s_waitcnt lgkmcnt(0)" ::: "memory")
__device__ __forceinline__ unsigned f2bf(float f) { unsigned u = __builtin_bit_cast(unsigned, f); return (u + 0x7fffu + ((u >> 16) & 1u)) >> 16; }
__device__ __forceinline__ unsigned pk2(float lo, float hi) { return f2bf(lo) | (f2bf(hi) << 16); }
__device__ __forceinline__ float bf_lo(unsigned w) { return __builtin_bit_cast(float, w << 16); }
__device__ __forceinline__ float bf_hi(unsigned w) { return __builtin_bit_cast(float, w & 0xffff0000u); }
__device__ __forceinline__ float bf2f(bf16 b) { return __builtin_bit_cast(float, (unsigned)b << 16); }
__device__ __forceinline__ float silu(float x) { return x / (1.0f + __expf(-x)); }
__device__ __forceinline__ float softplus(float x) { return x > 20.f ? x : log1pf(__expf(x)); }
__device__ __forceinline__ float wave_sum(float v) {
#pragma unroll
    for (int o = 1; o < 64; o <<= 1) v += __shfl_xor(v, o);
    return v;
}
#define XB_TMO      128
#define XB_XCNT(j)  (256  + 64 * (j))
#define XB_XSUB(j)  (1280 + 64 * (j))
#define XB_XGEN(j)  (2304 + 64 * (j))
#define XB_TOP      3328
#define XB_TOPGEN   3392
#define XCD_BAR_WORDS 3456
#define XB_SPIN_CAP (1u << 18)

__device__ __forceinline__ unsigned xb_ld(unsigned* p)              { return __hip_atomic_load(p, __ATOMIC_RELAXED, __HIP_MEMORY_SCOPE_AGENT); }
__device__ __forceinline__ unsigned xb_add(unsigned* p, unsigned v) { return __hip_atomic_fetch_add(p, v, __ATOMIC_RELAXED, __HIP_MEMORY_SCOPE_AGENT); }
__device__ __forceinline__ unsigned xb_xcc_id() { return (unsigned)__builtin_amdgcn_s_getreg((3 << 11) | 20) & 0xFu; }
#define XB_SPIN(cond, bar) do { unsigned _sp = 0; while (cond) { __builtin_amdgcn_s_sleep(1); \
    if ((++_sp & 255u) == 0u) { if (xb_ld(&(bar)[XB_TMO])) break; if (_sp > XB_SPIN_CAP) { atomicAdd(&(bar)[XB_TMO], 1u); break; } } } } while (0)

struct XcdBarrier {
    unsigned* bar; unsigned x;
    volatile LAS unsigned* st;
};

__device__ __forceinline__ XcdBarrier xcd_barrier_post(unsigned* bar, volatile LAS unsigned* st) {
    XcdBarrier b; b.bar = bar; b.x = xb_xcc_id(); b.st = st;
    if (threadIdx.x == 0) (void)xb_add(&bar[XB_XCNT(b.x)], 1u);
    return b;
}
__device__ __forceinline__ void xcd_barrier_complete(unsigned* bar, unsigned x, unsigned& nloc, unsigned& nx) {
    const unsigned G = gridDim.x * gridDim.y * gridDim.z;
    unsigned sum, cnt, mine, sp = 0u;
    for (;;) {
        sum = 0u; cnt = 0u; mine = 0u;
#pragma unroll
        for (unsigned j = 0; j < 16; ++j) { const unsigned c = xb_ld(&bar[XB_XCNT(j)]); sum += c; cnt += (c > 0u) ? 1u : 0u; mine = (j == x) ? c : mine; }
        if (sum == G) break;
        __builtin_amdgcn_s_sleep(1);
        if ((++sp & 255u) == 0u) { if (xb_ld(&bar[XB_TMO])) break; if (sp > XB_SPIN_CAP) { atomicAdd(&bar[XB_TMO], 1u); break; } }
    }
    nloc = mine > 0u ? mine : 1u; nx = cnt > 0u ? cnt : 1u;
}

__device__ __forceinline__ void xcd_barrier(const XcdBarrier& b) {
    asm volatile("s_waitcnt vmcnt(0)" ::: "memory");
    __syncthreads();
    if (threadIdx.x == 0) {
        unsigned* bar = b.bar;
        __builtin_amdgcn_s_waitcnt(0);
        unsigned nloc = b.st[0], nx = b.st[1];
        if (nloc == 0u) { xcd_barrier_complete(bar, b.x, nloc, nx); b.st[0] = nloc; b.st[1] = nx; }
        const unsigned old = xb_add(&bar[XB_XSUB(b.x)], 1u);
        const unsigned gen = old / nloc;
        if (old + 1u == (gen + 1u) * nloc) {
            __builtin_amdgcn_fence(__ATOMIC_RELEASE, "agent");
            asm volatile("s_waitcnt vmcnt(0)" ::: "memory");
            const unsigned og = xb_add(&bar[XB_TOP], 1u);
            const unsigned tg = og / nx;
            if (og + 1u == (tg + 1u) * nx) xb_add(&bar[XB_TOPGEN], 1u);
            else XB_SPIN(xb_ld(&bar[XB_TOPGEN]) == tg, bar);
            __builtin_amdgcn_fence(__ATOMIC_ACQUIRE, "agent");
            xb_add(&bar[XB_XGEN(b.x)], 1u);
            asm volatile("s_waitcnt vmcnt(0)" ::: "memory");
        } else {
            XB_SPIN(xb_ld(&bar[XB_XGEN(b.x)]) == gen, bar);
            __builtin_amdgcn_fence(__ATOMIC_ACQUIRE, "agent");
            asm volatile("s_waitcnt vmcnt(0)" ::: "memory");
        }
    }
    __syncthreads();
}

struct Ctx { int tid, lane, wave, G, vcu, gw, NGW, gtid, NT; };

__device__ __forceinline__ void tr_item(const float* W, int K, int Nsrc, int n0, int k0, bf16* WT, int d0, LAS float* scr, int lane) {
    const int n = n0 + (lane & 31); const bool ok = n < Nsrc;
#pragma unroll 8
    for (int i = 0; i < 32; ++i) { const int kk = 2 * i + (lane >> 5); scr[kk * 33 + (lane & 31)] = ok ? W[(size_t)(k0 + kk) * Nsrc + n] : 0.f; }
    LDS_WAIT(); asm volatile("" ::: "memory");
    const int c = lane & 7;
#pragma unroll
    for (int j = 0; j < 4; ++j) { const int nn = (lane >> 3) + 8 * j; const LAS float* s = scr + (8 * c) * 33 + nn;
        v4u o; o.x = pk2(s[0 * 33], s[1 * 33]); o.y = pk2(s[2 * 33], s[3 * 33]); o.z = pk2(s[4 * 33], s[5 * 33]); o.w = pk2(s[6 * 33], s[7 * 33]);
        *(v4u*)(WT + (size_t)(d0 + nn) * K + k0 + 8 * c) = o; }
    LDS_WAIT(); asm volatile("" ::: "memory");
}
template <int MODE> __device__ __forceinline__ void convert_matrix(const Ctx& c, LAS float* scr, const float* W, int K, int Nsrc, int Ndst, bf16* WT) {
    const int nblk = Ndst / 32, nitems = (K / 64) * nblk;
    for (int it = c.gw; it < nitems; it += c.NGW) {
        const int kb = it / nblk, nb = it % nblk, d0 = 32 * nb;
        int n0 = d0;
        if (MODE == 1) { const int pn = d0 >> 8, bj = (d0 >> 7) & 1, j0 = d0 & 127; n0 = bj * DFF + 128 * pn + j0; }
        tr_item(W, K, Nsrc, n0, 64 * kb, WT, d0, scr, c.lane);
    }
}

template <bool OUT_BF16> __device__ __forceinline__ void rmsnorm_rows(const Ctx& c, const float* X, const float* gain, void* out) {
    for (int m = c.gw; m < SEQ; m += c.NGW) {
        const f32x4* xr = (const f32x4*)(X + (size_t)m * DM) + c.lane;
        f32x4 v[8]; float s = 0.f;
#pragma unroll
        for (int j = 0; j < 8; ++j) { v[j] = xr[64 * j]; s += (v[j].x * v[j].x + v[j].y * v[j].y) + (v[j].z * v[j].z + v[j].w * v[j].w); }
        const float rs = rsqrtf(wave_sum(s) * (1.f / DM) + EPS);
        const f32x4* gr = (const f32x4*)gain + c.lane;
#pragma unroll
        for (int j = 0; j < 8; ++j) { const f32x4 g = gr[64 * j]; const f32x4 o = v[j] * rs * g;
            if (OUT_BF16) { v2u w; w.x = pk2(o.x, o.y); w.y = pk2(o.z, o.w); *((v2u*)((bf16*)out + (size_t)m * DM) + c.lane + 64 * j) = w; }
            else *((f32x4*)((float*)out + (size_t)m * DM) + c.lane + 64 * j) = o; }
    }
}

__device__ __forceinline__ void ssd_conv_dt(const Ctx& c, const bf16* ZX, const float* cw, const float* cb, const float* DTR, const float* dtb, bf16* XC, float* DT) {
    constexpr int NV = S_CONVD / 8;
    for (int it = c.gtid; it < SEQ * NV; it += c.NT) {
        const int t = it / NV, ch = (it % NV) * 8;
        float a[8];
#pragma unroll
        for (int j = 0; j < 8; ++j) a[j] = cb[ch + j];
#pragma unroll
        for (int k = 0; k < 4; ++k) { const int ts = t - 3 + k;
            if (ts >= 0) { const v4u x = *(const v4u*)(ZX + (size_t)ts * S_ZX + S_DI + ch);
                const unsigned xw[4] = {x.x, x.y, x.z, x.w};
#pragma unroll
                for (int j = 0; j < 4; ++j) { a[2 * j] += bf_lo(xw[j]) * cw[(ch + 2 * j) * 4 + k]; a[2 * j + 1] += bf_hi(xw[j]) * cw[(ch + 2 * j + 1) * 4 + k]; } } }
        v4u o; o.x = pk2(silu(a[0]), silu(a[1])); o.y = pk2(silu(a[2]), silu(a[3])); o.z = pk2(silu(a[4]), silu(a[5])); o.w = pk2(silu(a[6]), silu(a[7]));
        *(v4u*)(XC + (size_t)t * S_CONVD + ch) = o;
    }
    for (int it = c.gtid; it < SEQ * 64; it += c.NT) DT[it] = softplus(DTR[it] + dtb[it & 63]);
}
__device__ __forceinline__ void ssd_scan_naive(const Ctx& c, const bf16* XC, const bf16* ZX, const float* DT, const float* a_log, const float* dskip, float* YG) {
    for (int item = c.gw; item < S_NH * S_P; item += c.NGW) {
        const int h = item >> 6, p = item & 63, g = h >> 3;
        const float a = -__expf(a_log[h]), Dh = dskip[h];
        float s0 = 0.f, s1 = 0.f;
        const bf16* xcol = XC + h * 64 + p; const bf16* bcol = XC + S_DI + g * S_N + 2 * c.lane; const bf16* ccol = XC + S_DI + S_G * S_N + g * S_N + 2 * c.lane;
        const bf16* zcol = ZX + h * 64 + p; const float* dtp = DT + h;
        for (int t0 = 0; t0 < SEQ; t0 += 8) {
            float dtv[8], xv[8], zv[8]; unsigned bb[8], cc[8];
#pragma unroll
            for (int j = 0; j < 8; ++j) { const size_t t = t0 + j; dtv[j] = dtp[t * 64]; xv[j] = bf2f(xcol[t * S_CONVD]); zv[j] = bf2f(zcol[t * S_ZX]);
                bb[j] = *(const unsigned*)(bcol + t * S_CONVD); cc[j] = *(const unsigned*)(ccol + t * S_CONVD); }
#pragma unroll
            for (int j = 0; j < 8; ++j) { const float dA = __expf(dtv[j] * a), xd = dtv[j] * xv[j];
                s0 = s0 * dA + xd * bf_lo(bb[j]); s1 = s1 * dA + xd * bf_hi(bb[j]);
                const float y = wave_sum(bf_lo(cc[j]) * s0 + bf_hi(cc[j]) * s1) + Dh * xv[j];
                if (c.lane == 0) YG[(size_t)(t0 + j) * S_DI + h * 64 + p] = y * silu(zv[j]); }
        }
    }
}
__device__ __forceinline__ void ssd_groupnorm(const Ctx& c, const float* YG, const float* nw, bf16* MIX) {
    for (int it = c.gw; it < SEQ * S_G; it += c.NGW) {
        const size_t off = (size_t)it * 512 + 8 * c.lane; const int col = (it & 7) * 512 + 8 * c.lane;
        const f32x4 a = *(const f32x4*)(YG + off), b = *(const f32x4*)(YG + off + 4);
        const float ss = (a.x * a.x + a.y * a.y) + (a.z * a.z + a.w * a.w) + (b.x * b.x + b.y * b.y) + (b.z * b.z + b.w * b.w);
        const float rs = rsqrtf(wave_sum(ss) * (1.f / 512.f) + EPS);
        const f32x4 wa = *(const f32x4*)(nw + col), wb = *(const f32x4*)(nw + col + 4);
        v4u o; o.x = pk2(a.x * rs * wa.x, a.y * rs * wa.y); o.y = pk2(a.z * rs * wa.z, a.w * rs * wa.w); o.z = pk2(b.x * rs * wb.x, b.y * rs * wb.y); o.w = pk2(b.z * rs * wb.z, b.w * rs * wb.w);
        *(v4u*)(MIX + off) = o;
    }
}

__device__ __forceinline__ void gla_gate(const Ctx& c, const float* GL, const float* w2, const float* bg, float* AG) {
    for (int it = c.gtid; it < SEQ * G_DK; it += c.NT) {
        const int t = it >> 10, cc = it & 1023; float x = bg[cc];
#pragma unroll
        for (int r = 0; r < 16; ++r) x += GL[t * 16 + r] * w2[r * G_DK + cc];
        const float ls = -softplus(-x);
        AG[it] = __expf(ls * (1.f / 16.f));
    }
}
__device__ __forceinline__ void gla_scan_naive(const Ctx& c, const bf16* QKVR, const float* AG, float* OG) {
    for (int item = c.gw; item < G_H * G_HV; item += c.NGW) {
        const int h = item >> 9, v = item & 511;
        float S0 = 0.f, S1 = 0.f, S2 = 0.f, S3 = 0.f;
        const float* ap = AG + h * G_HK + 4 * c.lane; const bf16* qp = QKVR + h * G_HK + 4 * c.lane; const bf16* kp = QKVR + G_DK + h * G_HK + 4 * c.lane; const bf16* vp = QKVR + 2 * G_DK + h * G_HV + v;
        for (int t0 = 0; t0 < SEQ; t0 += 4) {
            f32x4 a4[4]; v2u k4[4], q4[4]; float vv[4];
#pragma unroll
            for (int j = 0; j < 4; ++j) { const size_t t = t0 + j; a4[j] = *(const f32x4*)(ap + t * G_DK); k4[j] = *(const v2u*)(kp + t * G_QKVR); q4[j] = *(const v2u*)(qp + t * G_QKVR); vv[j] = bf2f(vp[t * G_QKVR]); }
#pragma unroll
            for (int j = 0; j < 4; ++j) {
                S0 = S0 * a4[j].x + bf_lo(k4[j].x) * vv[j]; S1 = S1 * a4[j].y + bf_hi(k4[j].x) * vv[j]; S2 = S2 * a4[j].z + bf_lo(k4[j].y) * vv[j]; S3 = S3 * a4[j].w + bf_hi(k4[j].y) * vv[j];
                const float o = wave_sum((bf_lo(q4[j].x) * S0 + bf_hi(q4[j].x) * S1) + (bf_lo(q4[j].y) * S2 + bf_hi(q4[j].y) * S3)) * (1.f / 16.f);
                if (c.lane == 0) OG[(size_t)(t0 + j) * G_DV + h * G_HV + v] = o; }
        }
    }
}
__device__ __forceinline__ void gla_outnorm(const Ctx& c, const float* OG, const bf16* QKVR, const float* nw, bf16* MIX) {
    for (int it = c.gw; it < SEQ * G_H; it += c.NGW) {
        const int t = it >> 2, h = it & 3; const size_t off = (size_t)it * 512 + 8 * c.lane;
        const f32x4 a = *(const f32x4*)(OG + off), b = *(const f32x4*)(OG + off + 4);
        const float ss = (a.x * a.x + a.y * a.y) + (a.z * a.z + a.w * a.w) + (b.x * b.x + b.y * b.y) + (b.z * b.z + b.w * b.w);
        const float rs = rsqrtf(wave_sum(ss) * (1.f / 512.f) + EPS);
        const f32x4 wa = *(const f32x4*)(nw + 8 * c.lane), wb = *(const f32x4*)(nw + 8 * c.lane + 4);
        const v4u r = *(const v4u*)(QKVR + (size_t)t * G_QKVR + 2 * G_DK + G_DV + h * G_HV + 8 * c.lane);
        v4u o; o.x = pk2(a.x * rs * wa.x * silu(bf_lo(r.x)), a.y * rs * wa.y * silu(bf_hi(r.x))); o.y = pk2(a.z * rs * wa.z * silu(bf_lo(r.y)), a.w * rs * wa.w * silu(bf_hi(r.y)));
        o.z = pk2(b.x * rs * wb.x * silu(bf_lo(r.z)), b.y * rs * wb.y * silu(bf_hi(r.z))); o.w = pk2(b.z * rs * wb.z * silu(bf_lo(r.w)), b.w * rs * wb.w * silu(bf_hi(r.w)));
        *(v4u*)(MIX + off) = o;
    }
}

__device__ __forceinline__ void sgu_rstd(const Ctx& c, const bf16* ZZ, float* RS) {
    for (int t = c.gw; t < SEQ; t += c.NGW) {
        const v4u* p = (const v4u*)(ZZ + (size_t)t * 8192 + U_W) + c.lane; float s = 0.f;
#pragma unroll
        for (int j = 0; j < 8; ++j) { const v4u x = p[64 * j]; const unsigned w[4] = {x.x, x.y, x.z, x.w};
#pragma unroll
            for (int i = 0; i < 4; ++i) { const float lo = bf_lo(w[i]), hi = bf_hi(w[i]); s += lo * lo + hi * hi; } }
        s = wave_sum(s);
        if (c.lane == 0) RS[t] = rsqrtf(s * (1.f / U_W) + EPS);
    }
}
__device__ __forceinline__ void sgu_mix_naive(const Ctx& c, const bf16* ZZ, const float* RS, const float* WS, const float* BS, const float* nw, bf16* MIX) {
    for (int it = c.gw; it < SEQ * U_G; it += c.NGW) {
        const int g = it & 7, t = it >> 3, c0 = t & ~127, tt = t & 127;
        float acc[8];
#pragma unroll
        for (int j = 0; j < 8; ++j) acc[j] = 0.f;
        const float* wrow = WS + (size_t)g * 16384 + tt * 128;
        for (int s = 0; s <= tt; ++s) { const float w = wrow[s] * RS[c0 + s];
            const v4u x = *(const v4u*)(ZZ + (size_t)(c0 + s) * 8192 + U_W + g * 512 + 8 * c.lane); const unsigned xw[4] = {x.x, x.y, x.z, x.w};
#pragma unroll
            for (int j = 0; j < 4; ++j) { acc[2 * j] += w * bf_lo(xw[j]); acc[2 * j + 1] += w * bf_hi(xw[j]); } }
        const v4u uu = *(const v4u*)(ZZ + (size_t)t * 8192 + g * 512 + 8 * c.lane); const unsigned uw[4] = {uu.x, uu.y, uu.z, uu.w};
        const float b = BS[g * 128 + tt]; const float* nwp = nw + g * 512 + 8 * c.lane;
        v4u o; unsigned ow[4];
#pragma unroll
        for (int j = 0; j < 4; ++j) ow[j] = pk2(bf_lo(uw[j]) * (acc[2 * j] * nwp[2 * j] + b), bf_hi(uw[j]) * (acc[2 * j + 1] * nwp[2 * j + 1] + b));
        o.x = ow[0]; o.y = ow[1]; o.z = ow[2]; o.w = ow[3];
        *(v4u*)(MIX + (size_t)t * U_W + g * 512 + 8 * c.lane) = o;
    }
}
constexpr int NPH = 74, PH_FINAL = 73;
enum { KIND_SSD = 0, KIND_GLA = 1, KIND_SGU = 2, KIND_FFN = 3 };
__host__ __device__ inline int step_kind(int s) { return (s % 3 == 1) ? ((s / 3) % 3) : KIND_FFN; }
__host__ __device__ inline bool slot_used(int k) {
    if (k == 0 || k == PH_FINAL) return true;
    const int s = (k - 1) / 6, j = (k - 1) % 6, kind = step_kind(s);
    if (kind == KIND_FFN) return j <= 1 || j == 5;
    if (kind == KIND_SGU) return j != 4;
    return true;
}
__device__ __forceinline__ int opaque_idx(int i) { asm volatile("" : "+s"(i)); return i; }
struct Args { const float* in[25]; float* out; unsigned char* ws; int ph_lo, ph_hi; };

__global__ void __launch_bounds__(NWAVES * 64, 2) mk_fwd(Args args) {
    extern __shared__ __attribute__((aligned(16))) unsigned char lds_raw[];
    LAS unsigned char* lds = (LAS unsigned char*)lds_raw;
    volatile LAS unsigned* MISC = (volatile LAS unsigned*)(lds + MISC_OFF);
    Ctx c0; c0.tid = threadIdx.x; c0.lane = c0.tid & 63; c0.wave = __builtin_amdgcn_readfirstlane(c0.tid >> 6);
    c0.G = gridDim.x; { const int bx = blockIdx.x; c0.vcu = (c0.G % 8 == 0) ? (bx % 8) * (c0.G / 8) + bx / 8 : bx; }
    c0.gw = c0.vcu * NWAVES + c0.wave; c0.NGW = c0.G * NWAVES; c0.gtid = c0.vcu * (NWAVES * 64) + c0.tid; c0.NT = c0.G * NWAVES * 64;
    unsigned char* ws = args.ws;
    unsigned* ctl = (unsigned*)(ws + WS_CTL);
    for (int u = c0.tid; u < (LDS_BYTES - LDSCTL_OFF) / 4; u += NWAVES * 64) ((LAS unsigned*)(lds + LDSCTL_OFF))[u] = 0u;
    __syncthreads();
    const int lo = args.ph_lo, hi = args.ph_hi;
    const bool fused = (hi - lo) > 1;
    XcdBarrier bar; bar.bar = ctl + CW_BAR; bar.x = 0; bar.st = nullptr;
    if (fused) bar = xcd_barrier_post(ctl + CW_BAR, MISC + 8);
#define IN(k) (lo <= (k) && (k) < hi)
#define SEAM() do { if (fused) xcd_barrier(bar); } while (0)
#define FRESH() Ctx c = c0; asm volatile("" : "+v"(c.tid), "+v"(c.lane), "+v"(c.gtid)); asm volatile("" : "+s"(c.gw), "+s"(c.NGW), "+s"(c.NT))
#define INP(i) (args.in[opaque_idx(i)])

    float* H = (float*)(ws + WS_H); bf16* HN = (bf16*)(ws + WS_HN); bf16* BIG = (bf16*)(ws + WS_BIG); bf16* MIX = (bf16*)(ws + WS_MIX);
    unsigned char* scr = ws + WS_SCR;

    if (IN(0)) {
        FRESH();
        LAS float* tscr = (LAS float*)(lds + RING_OFF + c.wave * 16384);
        for (int i = 0; i < 8; ++i) {
            convert_matrix<1>(c, tscr, INP(2) + (size_t)i * DM * 2 * DFF, DM, 2 * DFF, 2 * DFF, (bf16*)(ws + WS_W_FFN_IN + i * SZ_FFN_IN));
            convert_matrix<0>(c, tscr, INP(3) + (size_t)i * DFF * DM, DFF, DM, DM, (bf16*)(ws + WS_W_FFN_OUT + i * SZ_FFN_OUT));
        }
        for (int i = 0; i < 2; ++i) {
            convert_matrix<0>(c, tscr, INP(5) + (size_t)i * DM * S_IN, DM, S_IN, S_INP, (bf16*)(ws + WS_W_SSD_IN + i * SZ_SSD_IN));
            convert_matrix<0>(c, tscr, INP(12) + (size_t)i * S_DI * DM, S_DI, DM, DM, (bf16*)(ws + WS_W_SSD_OUT + i * SZ_SSD_OUT));
        }
        convert_matrix<0>(c, tscr, INP(13), DM, G_IN, G_INP, (bf16*)(ws + WS_W_GLA_IN));
        convert_matrix<0>(c, tscr, INP(17), G_DV, DM, DM, (bf16*)(ws + WS_W_GLA_OUT));
        convert_matrix<0>(c, tscr, INP(18), DM, 2 * U_W, 2 * U_W, (bf16*)(ws + WS_W_SGU_IN));
        convert_matrix<0>(c, tscr, INP(23), U_W, DM, DM, (bf16*)(ws + WS_W_SGU_OUT));
        { const f32x4* src = (const f32x4*)INP(0); f32x4* dst = (f32x4*)H;
          for (int i = c.gtid; i < SEQ * DM / 4; i += c.NT) dst[i] = src[i]; }
        SEAM();
    }

    for (int s = 0; s < 3 * DEPTH; ++s) {
        const int base = 1 + 6 * s, layer = s / 3, sub = s % 3, kind = step_kind(s), mj = layer / 3, fi = layer * 2 + (sub >> 1);
        if (IN(base)) {
            FRESH();
            const float* gain = (sub == 1) ? INP(4) + (size_t)layer * DM : INP(1) + (size_t)fi * DM;
            rmsnorm_rows<true>(c, H, gain, HN);
            SEAM();
        }
        if (IN(base + 1)) {
            if (kind == KIND_FFN) {
                pg8::Gemm g{HN, (const bf16*)(ws + WS_W_FFN_IN + fi * SZ_FFN_IN), SEQ, 2 * DFF, DM}; pg8::StaticOrder S; S.init(SEQ, 2 * DFF, c0.G, (int)blockIdx.x);
                pg8::EpiSwiGLU E{BIG, DFF};
                pg8::gemm_phase<pg8::EpiSwiGLU, pg8::StaticOrder, true, true>(lds + RING_OFF, g, S, E);
            } else {
                const bf16* W = (const bf16*)(ws + (kind == KIND_SSD ? WS_W_SSD_IN + mj * SZ_SSD_IN : kind == KIND_GLA ? WS_W_GLA_IN : WS_W_SGU_IN));
                const int Np = kind == KIND_SSD ? S_INP : kind == KIND_GLA ? G_INP : 2 * U_W, ldo = kind == KIND_SSD ? S_ZX : kind == KIND_GLA ? G_QKVR : 2 * U_W;
                pg8::Gemm g{HN, W, SEQ, Np, DM}; pg8::StaticOrder S; S.init(SEQ, Np, c0.G, (int)blockIdx.x);
                pg8::EpiBf16X E{BIG, ldo, kind == KIND_SGU ? INP(19) : nullptr, ldo / 256, (float*)(scr + (kind == KIND_SSD ? SC_DTR : SC_GL)), kind == KIND_SSD ? 64 : 16};
                pg8::gemm_phase<pg8::EpiBf16X, pg8::StaticOrder, true, true>(lds + RING_OFF, g, S, E);
            }
            SEAM();
        }
        if (kind == KIND_SSD) {
            bf16* XC = (bf16*)(scr + SC_XC); float* DTR = (float*)(scr + SC_DTR); float* DT = (float*)(scr + SC_DT); float* YG = (float*)(scr + SC_YG);
            if (IN(base + 2)) { FRESH(); ssd_conv_dt(c, BIG, INP(6) + (size_t)mj * S_CONVD * 4, INP(7) + (size_t)mj * S_CONVD, DTR, INP(8) + mj * 64, XC, DT); SEAM(); }
            if (IN(base + 3)) { FRESH(); ssd_scan_naive(c, XC, BIG, DT, INP(9) + mj * 64, INP(10) + mj * 64, YG); SEAM(); }
            if (IN(base + 4)) { FRESH(); ssd_groupnorm(c, YG, INP(11) + (size_t)mj * S_DI, MIX); SEAM(); }
        } else if (kind == KIND_GLA) {
            float* GL = (float*)(scr + SC_GL); float* AG = (float*)(scr + SC_AG); float* OG = (float*)(scr + SC_OG);
            if (IN(base + 2)) { FRESH(); gla_gate(c, GL, INP(14), INP(15), AG); SEAM(); }
            if (IN(base + 3)) { FRESH(); gla_scan_naive(c, BIG, AG, OG); SEAM(); }
            if (IN(base + 4)) { FRESH(); gla_outnorm(c, OG, BIG, INP(16), MIX); SEAM(); }
        } else if (kind == KIND_SGU) {
            float* RS = (float*)(scr + SC_RS);
            if (IN(base + 2)) { FRESH(); sgu_rstd(c, BIG, RS); SEAM(); }
            if (IN(base + 3)) { FRESH(); sgu_mix_naive(c, BIG, RS, INP(21), INP(22), INP(20), MIX); SEAM(); }
        }
        if (IN(base + 5)) {
            const bf16* A = kind == KIND_FFN ? BIG : MIX;
            const bf16* W = (const bf16*)(ws + (kind == KIND_FFN ? WS_W_FFN_OUT + fi * SZ_FFN_OUT : kind == KIND_SSD ? WS_W_SSD_OUT + mj * SZ_SSD_OUT : kind == KIND_GLA ? WS_W_GLA_OUT : WS_W_SGU_OUT));
            const int K = kind == KIND_FFN ? DFF : kind == KIND_GLA ? G_DV : 4096;
            pg8::Gemm g{A, W, SEQ, DM, K}; pg8::StaticOrder S; S.init(SEQ, DM, c0.G, (int)blockIdx.x);
            pg8::EpiResid E{H, DM, kind == KIND_FFN ? 0.5f : 1.0f};
            pg8::gemm_phase<pg8::EpiResid, pg8::StaticOrder, true, true>(lds + RING_OFF, g, S, E);
            SEAM();
        }
    }
    if (IN(PH_FINAL)) { FRESH(); rmsnorm_rows<false>(c, H, INP(24), args.out); }
#undef IN
#undef SEAM
#undef FRESH
#undef INP
}

extern "C" void kernel_launch(void* const* d_in, const int* in_sizes, int n_in, void* d_out, int out_size, void* d_ws, size_t ws_size, hipStream_t stream) {
    static int grid = 0;
    if (grid == 0) {
        if (n_in != 25 || out_size != SEQ * DM || ws_size < WS_END) { fprintf(stderr, "kernel_launch: unexpected problem (n_in %d, out %d, ws %zu < %zu)\n", n_in, out_size, ws_size, (size_t)WS_END); grid = -1; return; }
        int dev = 0, cus = 0, per_cu = 0;
        if (hipGetDevice(&dev) != hipSuccess || hipDeviceGetAttribute(&cus, hipDeviceAttributeMultiprocessorCount, dev) != hipSuccess) { grid = -1; return; }
        if (hipFuncSetAttribute((const void*)mk_fwd, hipFuncAttributeMaxDynamicSharedMemorySize, LDS_BYTES) != hipSuccess) { fprintf(stderr, "kernel_launch: hipFuncSetAttribute failed\n"); grid = -1; return; }
        if (hipOccupancyMaxActiveBlocksPerMultiprocessor(&per_cu, (const void*)mk_fwd, NWAVES * 64, LDS_BYTES) != hipSuccess || per_cu < 1) fprintf(stderr, "kernel_launch: occupancy query reports %d\n", per_cu);
        (void)hipGetLastError();
        grid = cus;
    }
    if (grid < 0) return;
    if (hipMemsetAsync((char*)d_ws + WS_CTL, 0, CTL_ZERO_BYTES, stream) != hipSuccess) return;
    Args a{};
    for (int i = 0; i < 25; ++i) a.in[i] = (const float*)d_in[i];
    a.out = (float*)d_out; a.ws = (unsigned char*)d_ws;
#if MK_PER_PHASE
    for (int k = 0; k < NPH; ++k) { if (!slot_used(k)) continue; a.ph_lo = k; a.ph_hi = k + 1;
        hipLaunchKernelGGL(mk_fwd, dim3(grid), dim3(NWAVES * 64), LDS_BYTES, stream, a); }
#else
    a.ph_lo = 0; a.ph_hi = NPH;
    hipLaunchKernelGGL(mk_fwd, dim3(grid), dim3(NWAVES * 64), LDS_BYTES, stream, a);
#endif
    const hipError_t le = hipPeekAtLastError();
    if (le != hipSuccess) fprintf(stderr, "kernel_launch: launch failed: %s\n", hipGetErrorName(le));
}
```

```cpp
#include <hip/hip_runtime.h>
#include <cstdio>
#include <cstdint>
#ifndef MK_PER_PHASE
#define MK_PER_PHASE 0
#endif
#undef MK_PER_PHASE
#define MK_PER_PHASE 0
namespace pg8 {
#define PG8_LAS __attribute__((address_space(3)))
typedef unsigned short bf16_t;
typedef short bf16x8 __attribute__((ext_vector_type(8)));
typedef float f32x4 __attribute__((ext_vector_type(4)));
typedef unsigned u32x4 __attribute__((ext_vector_type(4)));
constexpr int BM = 256, BK = 64, HALF = 128, HTB = HALF * BK * 2  , STAGE_BYTES = 8 * HTB, NXCD = 8, WGM = 8;

__host__ __device__ __forceinline__ int lds_byte(int r, int c) { const int st = (r >> 4) * 2 + (c >> 5), rr = r & 15, cc = c & 31, ob = rr * 64 + cc * 2; return st * 1024 + (ob ^ (((ob >> 9) & 1) << 5)); }
__host__ __device__ __forceinline__ void stage_rc(int b, int& R, int& C) { const int st = b / 1024, sb = b % 1024, swz = sb ^ (((sb >> 9) & 1) << 5); R = (st >> 1) * 16 + swz / 64; C = (st & 1) * 32 + (swz % 64) / 2; }
__host__ __device__ __forceinline__ int perm32(int rho) { const int n = rho >> 4, i = rho & 15; return 8 * (i >> 2) + 4 * n + (i & 3); }

struct Unit { int pm, pn; };
struct Gemm { const bf16_t* A; const bf16_t* Bt; int M, N, K; };

struct StaticOrder {
    int nM, nN, nwg, G, c;
    __host__ __device__ void init(int M, int N, int G_, int c_) { nM = M / BM; nN = N / BM; nwg = nM * nN; G = G_; c = c_; }
    __host__ __device__ bool next(int i, Unit& u) const {
        const long L = (long)i * G + c; if (L >= nwg) return false;
        int wgid = (int)L; { const int q = nwg / NXCD, r = nwg % NXCD, xcd = wgid % NXCD, off = wgid / NXCD; wgid = (xcd < r ? xcd * (q + 1) : r * (q + 1) + (xcd - r) * q) + off; }
        const int nig = WGM * nN, gid = wgid / nig, fm = gid * WGM, gsz = (nM - fm) < WGM ? (nM - fm) : WGM;
        u.pm = fm + ((wgid % nig) % gsz); u.pn = (wgid % nig) / gsz; return true;
    }
    __device__ __forceinline__ void a_ready(const Unit&) const {}
    __device__ __forceinline__ void done(const Unit&) const {}
};
__device__ __forceinline__ unsigned cvt_pk_bf16(float lo, float hi) { unsigned r; asm volatile("v_cvt_pk_bf16_f32 %0, %1, %2" : "=v"(r) : "v"(lo), "v"(hi)); return r; }
typedef float f32x2 __attribute__((ext_vector_type(2)));
__device__ __forceinline__ f32x2 gelu_pk(f32x2 v) {
    const f32x2 av = __builtin_elementwise_abs(v), d = av * 0.2316418882f + 1.0f;
    f32x2 t; t.x = __builtin_amdgcn_rcpf(d.x); t.y = __builtin_amdgcn_rcpf(d.y);
    f32x2 q = t * 0.5307027145f + (-0.7265760135f); q = q * t + 0.7107068705f; q = q * t + (-0.142248368f); q = q * t + 0.127414796f; q = q * t;
    const f32x2 s = (v * v) * (-0.72134752044f);
    f32x2 e; e.x = __builtin_amdgcn_exp2f(s.x); e.y = __builtin_amdgcn_exp2f(s.y);
    const f32x2 m = v * (q * e), r = v - m;
    f32x2 o; o.x = v.x < 0.f ? m.x : r.x; o.y = v.y < 0.f ? m.y : r.y; return o;
}
__device__ __forceinline__ float silu_f(float x) { return x / (1.0f + __expf(-x)); }
__device__ __forceinline__ u32x4 pack8(const f32x4 v0, const f32x4 v1) { u32x4 w; w.x = cvt_pk_bf16(v0[0], v0[1]); w.y = cvt_pk_bf16(v0[2], v0[3]); w.z = cvt_pk_bf16(v1[0], v1[1]); w.w = cvt_pk_bf16(v1[2], v1[3]); return w; }

struct EpiSwiGLU {
    static constexpr bool PERM = true, AFTER_DRAIN = false;
    bf16_t* O; int ldc;
    __device__ __forceinline__ void operator()(const f32x4 (&acc)[2][2][4][2], const Unit& u, int wr, int wc, int fr, int fq) const {
        const int row0 = u.pm * BM + wr * 64 + fr, col0 = u.pn * HALF + wc * 32 + 8 * fq;
#pragma unroll
        for (int ai = 0; ai < 2; ++ai)
#pragma unroll
            for (int m = 0; m < 4; ++m) { bf16_t* rowp = O + (size_t)(row0 + ai * HALF + m * 16) * ldc + col0;
                f32x4 o0, o1;
#pragma unroll
                for (int i = 0; i < 4; ++i) { o0[i] = silu_f(acc[ai][0][m][0][i]) * acc[ai][1][m][0][i]; o1[i] = silu_f(acc[ai][0][m][1][i]) * acc[ai][1][m][1][i]; }
                *(u32x4*)rowp = pack8(o0, o1); }
    }
};
struct EpiResid {
    static constexpr bool PERM = false, AFTER_DRAIN = false;
    float* H; int ldc; float scale;
    __device__ __forceinline__ void operator()(const f32x4 (&acc)[2][2][4][2], const Unit& u, int wr, int wc, int fr, int fq) const {
        const int row0 = u.pm * BM + wr * 64 + fr, col0 = u.pn * BM + wc * 32 + 4 * fq;
#pragma unroll
        for (int ai = 0; ai < 2; ++ai)
#pragma unroll
            for (int m = 0; m < 4; ++m) { float* rowp = H + (size_t)(row0 + ai * HALF + m * 16) * ldc + col0;
#pragma unroll
                for (int bj = 0; bj < 2; ++bj)
#pragma unroll
                    for (int n = 0; n < 2; ++n) { f32x4* p = (f32x4*)(rowp + bj * HALF + n * 16); *p = *p + acc[ai][bj][m][n] * scale; } }
    }
};
struct EpiBf16X {
    static constexpr bool PERM = true, AFTER_DRAIN = false;
    bf16_t* O; int ldc; const float* bias; int npn_main; float* X; int nx;
    __device__ __forceinline__ void operator()(const f32x4 (&acc)[2][2][4][2], const Unit& u, int wr, int wc, int fr, int fq) const {
        const int row0 = u.pm * BM + wr * 64 + fr;
        if (u.pn < npn_main) {
            const int col0 = u.pn * BM + wc * 32 + 8 * fq;
            f32x4 bv[2][2];
#pragma unroll
            for (int bj = 0; bj < 2; ++bj)
#pragma unroll
                for (int n = 0; n < 2; ++n) bv[bj][n] = bias ? *(const f32x4*)(bias + col0 + bj * HALF + 4 * n) : (f32x4){0.f, 0.f, 0.f, 0.f};
#pragma unroll
            for (int ai = 0; ai < 2; ++ai)
#pragma unroll
                for (int m = 0; m < 4; ++m) { bf16_t* rowp = O + (size_t)(row0 + ai * HALF + m * 16) * ldc + col0;
#pragma unroll
                    for (int bj = 0; bj < 2; ++bj) { f32x4 v0 = acc[ai][bj][m][0] + bv[bj][0], v1 = acc[ai][bj][m][1] + bv[bj][1];
                        if (bias) { f32x2 a = gelu_pk((f32x2){v0[0], v0[1]}), b = gelu_pk((f32x2){v0[2], v0[3]}), c = gelu_pk((f32x2){v1[0], v1[1]}), d = gelu_pk((f32x2){v1[2], v1[3]});
                            v0 = (f32x4){a.x, a.y, b.x, b.y}; v1 = (f32x4){c.x, c.y, d.x, d.y}; }
                        *(u32x4*)(rowp + bj * HALF) = pack8(v0, v1); } }
        } else {
            const int c0 = wc * 32 + 8 * fq;
            if (c0 < nx) {
#pragma unroll
                for (int ai = 0; ai < 2; ++ai)
#pragma unroll
                    for (int m = 0; m < 4; ++m) { float* rowp = X + (size_t)(row0 + ai * HALF + m * 16) * nx + c0;
                        *(f32x4*)rowp = acc[ai][0][m][0]; *(f32x4*)(rowp + 4) = acc[ai][0][m][1]; }
            }
        }
    }
};
template <class Epi, class Sched, bool ALIGN_EPI = false, bool SP2 = false>
__device__ __forceinline__ void gemm_phase(PG8_LAS unsigned char* lds, const Gemm g, const Sched& S, const Epi& E) {
    int tid_ = threadIdx.x; asm volatile("" : "+v"(tid_));
    const int tid = tid_, wid = __builtin_amdgcn_readfirstlane(tid >> 6), lane = tid & 63, wr = wid >> 2, wc = wid & 3, fr = lane & 15, fq = lane >> 4;
    const int K = g.K, nt = K / BK;
    unsigned voffA[2], voffB[2];
#pragma unroll
    for (int i = 0; i < 2; ++i) { int R, C; stage_rc(tid * 16 + i * 8192, R, C); const int Rb = Epi::PERM ? ((R & ~31) + perm32(R & 31)) : R;
        voffA[i] = (unsigned)(R * K + C) * 2u; voffB[i] = (unsigned)(Rb * K + C) * 2u; }
    const size_t kstep = (size_t)(BK * 2);
    const size_t hstep = (size_t)HALF * K * 2;
    const size_t tstep = 2 * hstep;
    const unsigned ldsw = (unsigned)wid * 1024u;
    const int aoff = lds_byte(wr * 64 + fr, fq * 8), boff = lds_byte(wc * 32 + fr, fq * 8);
#define PG8_SA(b, h) (((b) * 2 + (h)) * HTB)
#define PG8_SB(b, h) ((4 + (b) * 2 + (h)) * HTB)
#define PG8_STAGE(bufoff, gbase, voff) do { _Pragma("unroll") for (int _i = 0; _i < 2; ++_i) \
        __builtin_amdgcn_global_load_lds((const unsigned*)((const char*)(gbase) + (voff)[_i]), (PG8_LAS unsigned*)(lds + (bufoff) + ldsw + _i * 8192), 16, 0, 0); } while (0)
#define PG8_LDA(dst, b, h) do { _Pragma("unroll") for (int m = 0; m < 4; ++m) _Pragma("unroll") for (int k = 0; k < 2; ++k) dst[m][k] = *(const PG8_LAS bf16x8*)(lds + PG8_SA(b, h) + aoff + m * 2048 + k * 1024); } while (0)
#define PG8_LDB(dst, b, h) do { _Pragma("unroll") for (int n = 0; n < 2; ++n) _Pragma("unroll") for (int k = 0; k < 2; ++k) dst[n][k] = *(const PG8_LAS bf16x8*)(lds + PG8_SB(b, h) + boff + n * 2048 + k * 1024); } while (0)
#define PG8_MMA(ai, bj, At, Bt) do { __builtin_amdgcn_s_setprio(1); _Pragma("unroll") for (int m = 0; m < 4; ++m) _Pragma("unroll") for (int n = 0; n < 2; ++n) _Pragma("unroll") for (int k = 0; k < 2; ++k) \
        acc[ai][bj][m][n] = __builtin_amdgcn_mfma_f32_16x16x32_bf16(Bt[n][k], At[m][k], acc[ai][bj][m][n], 0, 0, 0); __builtin_amdgcn_s_setprio(0); } while (0)
#define PG8_WAIT_V(n) asm volatile("s_waitcnt vmcnt(" #n ")" ::: "memory")
#define PG8_WAIT_L(n) asm volatile("s_waitcnt lgkmcnt(" #n ")" ::: "memory")
#define PG8_BAR __builtin_amdgcn_s_barrier()
#define PG8_SCHED __builtin_amdgcn_sched_barrier(0)
    Unit cur, nxt; int ui = 0;
    if (!S.next(0, cur)) return;
    f32x4 acc[2][2][4][2];
#pragma unroll
    for (int a = 0; a < 2; ++a)
#pragma unroll
        for (int b = 0; b < 2; ++b)
#pragma unroll
            for (int m = 0; m < 4; ++m)
#pragma unroll
                for (int n = 0; n < 2; ++n) acc[a][b][m][n] = (f32x4){0.f, 0.f, 0.f, 0.f};
    bf16x8 At[4][2], B0[2][2], B1[2][2];
    const char* cA = (const char*)g.A + (size_t)cur.pm * tstep; const char* cB = (const char*)g.Bt + (size_t)cur.pn * tstep;
    S.a_ready(cur);
    if constexpr (SP2) {
        PG8_STAGE(PG8_SB(0, 0), cB, voffB); PG8_STAGE(PG8_SB(0, 1), cB + hstep, voffB); PG8_STAGE(PG8_SA(0, 0), cA, voffA); PG8_STAGE(PG8_SA(0, 1), cA + hstep, voffA);
        if (wr == 1) PG8_BAR;
        PG8_WAIT_V(2); PG8_BAR;
        PG8_STAGE(PG8_SB(1, 0), cB + kstep, voffB); PG8_STAGE(PG8_SA(1, 0), cA + kstep, voffA); PG8_STAGE(PG8_SB(1, 1), cB + hstep + kstep, voffB);
        PG8_WAIT_V(6); PG8_BAR;
    } else {
        PG8_STAGE(PG8_SB(0, 0), cB, voffB); PG8_STAGE(PG8_SA(0, 0), cA, voffA); PG8_STAGE(PG8_SB(0, 1), cB + hstep, voffB); PG8_STAGE(PG8_SA(0, 1), cA + hstep, voffA);
        if (wr == 1) PG8_BAR;
        PG8_WAIT_V(4); PG8_BAR;
        PG8_STAGE(PG8_SB(1, 0), cB + kstep, voffB); PG8_STAGE(PG8_SA(1, 0), cA + kstep, voffA); PG8_STAGE(PG8_SB(1, 1), cB + hstep + kstep, voffB);
        PG8_WAIT_V(6); PG8_BAR;
    }
    for (;;) {
        const bool has_next = S.next(ui + 1, nxt);
        const char* nA = has_next ? (const char*)g.A + (size_t)nxt.pm * tstep : cA; const char* nB = has_next ? (const char*)g.Bt + (size_t)nxt.pn * tstep : cB;
        for (int t = 0; t < nt; t += 2) {
            const bool last = (t == nt - 2);
            const char* a1 = cA + (size_t)(t + 1) * kstep;
            const char* a2 = last ? nA : cA + (size_t)(t + 2) * kstep; const char* b2 = last ? nB : cB + (size_t)(t + 2) * kstep;
            const char* a3 = a2 + kstep; const char* b3 = b2 + kstep;
            if (last && has_next) S.a_ready(nxt);
            if constexpr (SP2) {
            PG8_LDB(B0, 0, 0); PG8_LDB(B1, 0, 1); PG8_SCHED; PG8_LDA(At, 0, 0); PG8_STAGE(PG8_SA(1, 1), a1 + hstep, voffA);
            PG8_WAIT_V(8); PG8_WAIT_L(0); PG8_BAR; PG8_MMA(0, 0, At, B0); PG8_MMA(0, 1, At, B1); PG8_BAR; PG8_SCHED;
            PG8_LDA(At, 0, 1); PG8_STAGE(PG8_SB(0, 0), b2, voffB); PG8_STAGE(PG8_SB(0, 1), b2 + hstep, voffB); PG8_STAGE(PG8_SA(0, 0), a2, voffA);
            PG8_WAIT_V(8); PG8_WAIT_L(0); PG8_BAR; PG8_MMA(1, 0, At, B0); PG8_MMA(1, 1, At, B1); PG8_BAR; PG8_SCHED;
            PG8_LDB(B0, 1, 0); PG8_LDB(B1, 1, 1); PG8_SCHED; PG8_LDA(At, 1, 0); PG8_STAGE(PG8_SA(0, 1), a2 + hstep, voffA);
            PG8_WAIT_V(8); PG8_WAIT_L(0); PG8_BAR; PG8_MMA(0, 0, At, B0); PG8_MMA(0, 1, At, B1); PG8_BAR; PG8_SCHED;
            PG8_LDA(At, 1, 1); PG8_STAGE(PG8_SB(1, 0), b3, voffB); PG8_STAGE(PG8_SB(1, 1), b3 + hstep, voffB); PG8_STAGE(PG8_SA(1, 0), a3, voffA);
            PG8_WAIT_V(8); PG8_WAIT_L(0); PG8_BAR; PG8_MMA(1, 0, At, B0); PG8_MMA(1, 1, At, B1); PG8_BAR; PG8_SCHED;
            } else {
            PG8_LDB(B0, 0, 0); PG8_SCHED; PG8_LDA(At, 0, 0); PG8_STAGE(PG8_SA(1, 1), a1 + hstep, voffA);
            PG8_WAIT_L(8); PG8_BAR; PG8_WAIT_L(0); PG8_MMA(0, 0, At, B0); PG8_BAR; PG8_SCHED;
            PG8_LDB(B1, 0, 1); PG8_STAGE(PG8_SB(0, 0), b2, voffB);
            PG8_BAR; PG8_WAIT_L(0); PG8_MMA(0, 1, At, B1); PG8_BAR;
            PG8_LDA(At, 0, 1); PG8_STAGE(PG8_SA(0, 0), a2, voffA);
            PG8_BAR; PG8_WAIT_L(0); PG8_MMA(1, 0, At, B0); PG8_BAR; PG8_SCHED;
            PG8_STAGE(PG8_SB(0, 1), b2 + hstep, voffB);
            PG8_WAIT_V(6); PG8_BAR; PG8_MMA(1, 1, At, B1); PG8_BAR;
            PG8_LDB(B0, 1, 0); PG8_SCHED; PG8_LDA(At, 1, 0); PG8_STAGE(PG8_SA(0, 1), a2 + hstep, voffA);
            PG8_WAIT_L(8); PG8_BAR; PG8_WAIT_L(0); PG8_MMA(0, 0, At, B0); PG8_BAR; PG8_SCHED;
            PG8_LDB(B1, 1, 1); PG8_STAGE(PG8_SB(1, 0), b3, voffB);
            PG8_BAR; PG8_WAIT_L(0); PG8_MMA(0, 1, At, B1); PG8_BAR;
            PG8_LDA(At, 1, 1); PG8_STAGE(PG8_SA(1, 0), a3, voffA);
            PG8_BAR; PG8_WAIT_L(0); PG8_MMA(1, 0, At, B0); PG8_BAR; PG8_SCHED;
            PG8_STAGE(PG8_SB(1, 1), b3 + hstep, voffB);
            PG8_WAIT_V(6); PG8_BAR; PG8_MMA(1, 1, At, B1); PG8_BAR;
            }
        }
        if constexpr (ALIGN_EPI) { if (wr == 0) PG8_BAR; }
        if constexpr (!Epi::AFTER_DRAIN) { E(acc, cur, wr, wc, fr, fq); S.done(cur); }
        if (!has_next) break;
#pragma unroll
        for (int a = 0; a < 2; ++a)
#pragma unroll
            for (int b = 0; b < 2; ++b)
#pragma unroll
                for (int m = 0; m < 4; ++m)
#pragma unroll
                    for (int n = 0; n < 2; ++n) acc[a][b][m][n] = (f32x4){0.f, 0.f, 0.f, 0.f};
        cur = nxt; cA = nA; cB = nB; ++ui;
        if constexpr (ALIGN_EPI) { if (wr == 1) PG8_BAR; }
    }
    PG8_WAIT_V(0);
    if constexpr (!ALIGN_EPI) { if (wr == 0) PG8_BAR; }
    PG8_BAR;
    if constexpr (Epi::AFTER_DRAIN) { E.fused(acc, cur, wr, wc, fr, fq, lds, wid, lane); S.done(cur); }
#undef PG8_SA
#undef PG8_SB
#undef PG8_STAGE
#undef PG8_LDA
#undef PG8_LDB
#undef PG8_MMA
#undef PG8_WAIT_V
#undef PG8_WAIT_L
#undef PG8_BAR
#undef PG8_SCHED
}
}
constexpr int SEQ = 8192, DM = 2048, DFF = 5632, DEPTH = 4, NWAVES = 8;
constexpr float EPS = 1e-6f;
constexpr int S_DI = 4096, S_NH = 64, S_P = 64, S_G = 8, S_N = 128, S_CONVD = 6144, S_IN = 10304, S_INP = 10496, S_ZX = 10240;
constexpr int G_H = 4, G_DK = 1024, G_DV = 2048, G_HK = 256, G_HV = 512, G_R = 16, G_IN = 6160, G_INP = 6400, G_QKVR = 6144;
constexpr int U_W = 4096, U_G = 8, U_GD = 512, U_Q = 128;

constexpr size_t MiB = 1u << 20;
constexpr size_t WS_CTL = 0, CTL_ZERO_BYTES = 1 * MiB;
constexpr size_t SZ_FFN_IN = (size_t)2 * DFF * DM * 2, SZ_FFN_OUT = (size_t)DM * DFF * 2;
constexpr size_t SZ_SSD_IN = (size_t)S_INP * DM * 2, SZ_SSD_OUT = (size_t)DM * S_DI * 2;
constexpr size_t WS_W_FFN_IN = 1 * MiB;
constexpr size_t WS_W_FFN_OUT = WS_W_FFN_IN + 8 * SZ_FFN_IN;
constexpr size_t WS_W_SSD_IN = WS_W_FFN_OUT + 8 * SZ_FFN_OUT;
constexpr size_t WS_W_SSD_OUT = WS_W_SSD_IN + 2 * SZ_SSD_IN;
constexpr size_t WS_W_GLA_IN = WS_W_SSD_OUT + 2 * SZ_SSD_OUT;
constexpr size_t WS_W_GLA_OUT = WS_W_GLA_IN + (size_t)G_INP * DM * 2;
constexpr size_t WS_W_SGU_IN = WS_W_GLA_OUT + (size_t)DM * G_DV * 2;
constexpr size_t WS_W_SGU_OUT = WS_W_SGU_IN + (size_t)2 * U_W * DM * 2;
constexpr size_t WS_W_END = WS_W_SGU_OUT + (size_t)DM * U_W * 2;
constexpr size_t WS_H = (WS_W_END + MiB - 1) / MiB * MiB;
constexpr size_t WS_HN = WS_H + (size_t)SEQ * DM * 4;
constexpr size_t WS_BIG = WS_HN + (size_t)SEQ * DM * 2;
constexpr size_t WS_MIX = WS_BIG + (size_t)SEQ * S_ZX * 2;
constexpr size_t WS_SCR = WS_MIX + (size_t)SEQ * 4096 * 2;
constexpr size_t WS_SCR_BYTES = 512 * MiB;
constexpr size_t WS_END = WS_SCR + WS_SCR_BYTES;
static_assert(WS_H % 256 == 0 && WS_W_SSD_IN % 256 == 0 && WS_W_GLA_IN % 256 == 0, "alignment");
constexpr size_t SC_XC = 0;
constexpr size_t SC_DTR = SC_XC + (size_t)SEQ * S_CONVD * 2;
constexpr size_t SC_DT = SC_DTR + (size_t)SEQ * 64 * 4;
constexpr size_t SC_YG = SC_DT + (size_t)SEQ * 64 * 4;
constexpr size_t SC_SSD_END = SC_YG + (size_t)SEQ * 4096 * 4;
constexpr size_t SC_GL = 0;
constexpr size_t SC_AG = SC_GL + (size_t)SEQ * 16 * 4;
constexpr size_t SC_OG = SC_AG + (size_t)SEQ * 1024 * 4;
constexpr size_t SC_GLA_END = SC_OG + (size_t)SEQ * 2048 * 4;
constexpr size_t SC_RS = 0;
static_assert(SC_SSD_END <= WS_SCR_BYTES && SC_GLA_END <= WS_SCR_BYTES, "scratch map");
constexpr int CW_BAR = 4096;

constexpr int RING_OFF = 0, RING_BYTES = 131072;
constexpr int LDSCTL_OFF = RING_BYTES, MISC_OFF = LDSCTL_OFF + 320;
constexpr int LDS_BYTES = 147456;

#define GAS __attribute__((address_space(1)))
#define LAS __attribute__((address_space(3)))
typedef unsigned short bf16;
typedef unsigned v4u __attribute__((ext_vector_type(4)));
typedef unsigned v2u __attribute__((ext_vector_type(2)));
typedef float f32x4 __attribute__((ext_vector_type(4)));
#define LDS_WAIT() asm volatile("s_waitcnt lgkmcnt(0)" ::: "memory")
__device__ __forceinline__ unsigned f2bf(float f) { unsigned u = __builtin_bit_cast(unsigned, f); return (u + 0x7fffu + ((u >> 16) & 1u)) >> 16; }
__device__ __forceinline__ unsigned pk2(float lo, float hi) { return f2bf(lo) | (f2bf(hi) << 16); }
__device__ __forceinline__ float bf_lo(unsigned w) { return __builtin_bit_cast(float, w << 16); }
__device__ __forceinline__ float bf_hi(unsigned w) { return __builtin_bit_cast(float, w & 0xffff0000u); }
__device__ __forceinline__ float bf2f(bf16 b) { return __builtin_bit_cast(float, (unsigned)b << 16); }
__device__ __forceinline__ float silu(float x) { return x / (1.0f + __expf(-x)); }
__device__ __forceinline__ float softplus(float x) { return x > 20.f ? x : log1pf(__expf(x)); }
__device__ __forceinline__ float wave_sum(float v) {
#pragma unroll
    for (int o = 1; o < 64; o <<= 1) v += __shfl_xor(v, o);
    return v;
}
#define XB_TMO      128
#define XB_XCNT(j)  (256  + 64 * (j))
#define XB_XSUB(j)  (1280 + 64 * (j))
#define XB_XGEN(j)  (2304 + 64 * (j))
#define XB_TOP      3328
#define XB_TOPGEN   3392
#define XCD_BAR_WORDS 3456
#define XB_SPIN_CAP (1u << 18)

__device__ __forceinline__ unsigned xb_ld(unsigned* p)              { return __hip_atomic_load(p, __ATOMIC_RELAXED, __HIP_MEMORY_SCOPE_AGENT); }
__device__ __forceinline__ unsigned xb_add(unsigned* p, unsigned v) { return __hip_atomic_fetch_add(p, v, __ATOMIC_RELAXED, __HIP_MEMORY_SCOPE_AGENT); }
__device__ __forceinline__ unsigned xb_xcc_id() { return (unsigned)__builtin_amdgcn_s_getreg((3 << 11) | 20) & 0xFu; }
#define XB_SPIN(cond, bar) do { unsigned _sp = 0; while (cond) { __builtin_amdgcn_s_sleep(1); \
    if ((++_sp & 255u) == 0u) { if (xb_ld(&(bar)[XB_TMO])) break; if (_sp > XB_SPIN_CAP) { atomicAdd(&(bar)[XB_TMO], 1u); break; } } } } while (0)

struct XcdBarrier {
    unsigned* bar; unsigned x;
    volatile LAS unsigned* st;
};

__device__ __forceinline__ XcdBarrier xcd_barrier_post(unsigned* bar, volatile LAS unsigned* st) {
    XcdBarrier b; b.bar = bar; b.x = xb_xcc_id(); b.st = st;
    if (threadIdx.x == 0) (void)xb_add(&bar[XB_XCNT(b.x)], 1u);
    return b;
}
__device__ __forceinline__ void xcd_barrier_complete(unsigned* bar, unsigned x, unsigned& nloc, unsigned& nx) {
    const unsigned G = gridDim.x * gridDim.y * gridDim.z;
    unsigned sum, cnt, mine, sp = 0u;
    for (;;) {
        sum = 0u; cnt = 0u; mine = 0u;
#pragma unroll
        for (unsigned j = 0; j < 16; ++j) { const unsigned c = xb_ld(&bar[XB_XCNT(j)]); sum += c; cnt += (c > 0u) ? 1u : 0u; mine = (j == x) ? c : mine; }
        if (sum == G) break;
        __builtin_amdgcn_s_sleep(1);
        if ((++sp & 255u) == 0u) { if (xb_ld(&bar[XB_TMO])) break; if (sp > XB_SPIN_CAP) { atomicAdd(&bar[XB_TMO], 1u); break; } }
    }
    nloc = mine > 0u ? mine : 1u; nx = cnt > 0u ? cnt : 1u;
}

__device__ __forceinline__ void xcd_barrier(const XcdBarrier& b) {
    asm volatile("s_waitcnt vmcnt(0)" ::: "memory");
    __syncthreads();
    if (threadIdx.x == 0) {
        unsigned* bar = b.bar;
        __builtin_amdgcn_s_waitcnt(0);
        unsigned nloc = b.st[0], nx = b.st[1];
        if (nloc == 0u) { xcd_barrier_complete(bar, b.x, nloc, nx); b.st[0] = nloc; b.st[1] = nx; }
        const unsigned old = xb_add(&bar[XB_XSUB(b.x)], 1u);
        const unsigned gen = old / nloc;
        if (old + 1u == (gen + 1u) * nloc) {
            __builtin_amdgcn_fence(__ATOMIC_RELEASE, "agent");
            asm volatile("s_waitcnt vmcnt(0)" ::: "memory");
            const unsigned og = xb_add(&bar[XB_TOP], 1u);
            const unsigned tg = og / nx;
            if (og + 1u == (tg + 1u) * nx) xb_add(&bar[XB_TOPGEN], 1u);
            else XB_SPIN(xb_ld(&bar[XB_TOPGEN]) == tg, bar);
            __builtin_amdgcn_fence(__ATOMIC_ACQUIRE, "agent");
            xb_add(&bar[XB_XGEN(b.x)], 1u);
            asm volatile("s_waitcnt vmcnt(0)" ::: "memory");
        } else {
            XB_SPIN(xb_ld(&bar[XB_XGEN(b.x)]) == gen, bar);
            __builtin_amdgcn_fence(__ATOMIC_ACQUIRE, "agent");
            asm volatile("s_waitcnt vmcnt(0)" ::: "memory");
        }
    }
    __syncthreads();
}

struct Ctx { int tid, lane, wave, G, vcu, gw, NGW, gtid, NT; };

__device__ __forceinline__ void tr_item(const float* W, int K, int Nsrc, int n0, int k0, bf16* WT, int d0, LAS float* scr, int lane) {
    const int n = n0 + (lane & 31); const bool ok = n < Nsrc;
#pragma unroll 8
    for (int i = 0; i < 32; ++i) { const int kk = 2 * i + (lane >> 5); scr[kk * 33 + (lane & 31)] = ok ? W[(size_t)(k0 + kk) * Nsrc + n] : 0.f; }
    LDS_WAIT(); asm volatile("" ::: "memory");
    const int c = lane & 7;
#pragma unroll
    for (int j = 0; j < 4; ++j) { const int nn = (lane >> 3) + 8 * j; const LAS float* s = scr + (8 * c) * 33 + nn;
        v4u o; o.x = pk2(s[0 * 33], s[1 * 33]); o.y = pk2(s[2 * 33], s[3 * 33]); o.z = pk2(s[4 * 33], s[5 * 33]); o.w = pk2(s[6 * 33], s[7 * 33]);
        *(v4u*)(WT + (size_t)(d0 + nn) * K + k0 + 8 * c) = o; }
    LDS_WAIT(); asm volatile("" ::: "memory");
}
template <int MODE> __device__ __forceinline__ void convert_matrix(const Ctx& c, LAS float* scr, const float* W, int K, int Nsrc, int Ndst, bf16* WT) {
    const int nblk = Ndst / 32, nitems = (K / 64) * nblk;
    for (int it = c.gw; it < nitems; it += c.NGW) {
        const int kb = it / nblk, nb = it % nblk, d0 = 32 * nb;
        int n0 = d0;
        if (MODE == 1) { const int pn = d0 >> 8, bj = (d0 >> 7) & 1, j0 = d0 & 127; n0 = bj * DFF + 128 * pn + j0; }
        tr_item(W, K, Nsrc, n0, 64 * kb, WT, d0, scr, c.lane);
    }
}

template <bool OUT_BF16> __device__ __forceinline__ void rmsnorm_rows(const Ctx& c, const float* X, const float* gain, void* out) {
    for (int m = c.gw; m < SEQ; m += c.NGW) {
        const f32x4* xr = (const f32x4*)(X + (size_t)m * DM) + c.lane;
        f32x4 v[8]; float s = 0.f;
#pragma unroll
        for (int j = 0; j < 8; ++j) { v[j] = xr[64 * j]; s += (v[j].x * v[j].x + v[j].y * v[j].y) + (v[j].z * v[j].z + v[j].w * v[j].w); }
        const float rs = rsqrtf(wave_sum(s) * (1.f / DM) + EPS);
        const f32x4* gr = (const f32x4*)gain + c.lane;
#pragma unroll
        for (int j = 0; j < 8; ++j) { const f32x4 g = gr[64 * j]; const f32x4 o = v[j] * rs * g;
            if (OUT_BF16) { v2u w; w.x = pk2(o.x, o.y); w.y = pk2(o.z, o.w); *((v2u*)((bf16*)out + (size_t)m * DM) + c.lane + 64 * j) = w; }
            else *((f32x4*)((float*)out + (size_t)m * DM) + c.lane + 64 * j) = o; }
    }
}

__device__ __forceinline__ void ssd_conv_dt(const Ctx& c, const bf16* ZX, const float* cw, const float* cb, const float* DTR, const float* dtb, bf16* XC, float* DT) {
    constexpr int NV = S_CONVD / 8;
    for (int it = c.gtid; it < SEQ * NV; it += c.NT) {
        const int t = it / NV, ch = (it % NV) * 8;
        float a[8];
#pragma unroll
        for (int j = 0; j < 8; ++j) a[j] = cb[ch + j];
#pragma unroll
        for (int k = 0; k < 4; ++k) { const int ts = t - 3 + k;
            if (ts >= 0) { const v4u x = *(const v4u*)(ZX + (size_t)ts * S_ZX + S_DI + ch);
                const unsigned xw[4] = {x.x, x.y, x.z, x.w};
#pragma unroll
                for (int j = 0; j < 4; ++j) { a[2 * j] += bf_lo(xw[j]) * cw[(ch + 2 * j) * 4 + k]; a[2 * j + 1] += bf_hi(xw[j]) * cw[(ch + 2 * j + 1) * 4 + k]; } } }
        v4u o; o.x = pk2(silu(a[0]), silu(a[1])); o.y = pk2(silu(a[2]), silu(a[3])); o.z = pk2(silu(a[4]), silu(a[5])); o.w = pk2(silu(a[6]), silu(a[7]));
        *(v4u*)(XC + (size_t)t * S_CONVD + ch) = o;
    }
    for (int it = c.gtid; it < SEQ * 64; it += c.NT) DT[it] = softplus(DTR[it] + dtb[it & 63]);
}
__device__ __forceinline__ void ssd_scan_naive(const Ctx& c, const bf16* XC, const bf16* ZX, const float* DT, const float* a_log, const float* dskip, float* YG) {
    for (int item = c.gw; item < S_NH * S_P; item += c.NGW) {
        const int h = item >> 6, p = item & 63, g = h >> 3;
        const float a = -__expf(a_log[h]), Dh = dskip[h];
        float s0 = 0.f, s1 = 0.f;
        const bf16* xcol = XC + h * 64 + p; const bf16* bcol = XC + S_DI + g * S_N + 2 * c.lane; const bf16* ccol = XC + S_DI + S_G * S_N + g * S_N + 2 * c.lane;
        const bf16* zcol = ZX + h * 64 + p; const float* dtp = DT + h;
        for (int t0 = 0; t0 < SEQ; t0 += 8) {
            float dtv[8], xv[8], zv[8]; unsigned bb[8], cc[8];
#pragma unroll
            for (int j = 0; j < 8; ++j) { const size_t t = t0 + j; dtv[j] = dtp[t * 64]; xv[j] = bf2f(xcol[t * S_CONVD]); zv[j] = bf2f(zcol[t * S_ZX]);
                bb[j] = *(const unsigned*)(bcol + t * S_CONVD); cc[j] = *(const unsigned*)(ccol + t * S_CONVD); }
#pragma unroll
            for (int j = 0; j < 8; ++j) { const float dA = __expf(dtv[j] * a), xd = dtv[j] * xv[j];
                s0 = s0 * dA + xd * bf_lo(bb[j]); s1 = s1 * dA + xd * bf_hi(bb[j]);
                const float y = wave_sum(bf_lo(cc[j]) * s0 + bf_hi(cc[j]) * s1) + Dh * xv[j];
                if (c.lane == 0) YG[(size_t)(t0 + j) * S_DI + h * 64 + p] = y * silu(zv[j]); }
        }
    }
}
__device__ __forceinline__ void ssd_groupnorm(const Ctx& c, const float* YG, const float* nw, bf16* MIX) {
    for (int it = c.gw; it < SEQ * S_G; it += c.NGW) {
        const size_t off = (size_t)it * 512 + 8 * c.lane; const int col = (it & 7) * 512 + 8 * c.lane;
        const f32x4 a = *(const f32x4*)(YG + off), b = *(const f32x4*)(YG + off + 4);
        const float ss = (a.x * a.x + a.y * a.y) + (a.z * a.z + a.w * a.w) + (b.x * b.x + b.y * b.y) + (b.z * b.z + b.w * b.w);
        const float rs = rsqrtf(wave_sum(ss) * (1.f / 512.f) + EPS);
        const f32x4 wa = *(const f32x4*)(nw + col), wb = *(const f32x4*)(nw + col + 4);
        v4u o; o.x = pk2(a.x * rs * wa.x, a.y * rs * wa.y); o.y = pk2(a.z * rs * wa.z, a.w * rs * wa.w); o.z = pk2(b.x * rs * wb.x, b.y * rs * wb.y); o.w = pk2(b.z * rs * wb.z, b.w * rs * wb.w);
        *(v4u*)(MIX + off) = o;
    }
}

__device__ __forceinline__ void gla_gate(const Ctx& c, const float* GL, const float* w2, const float* bg, float* AG) {
    for (int it = c.gtid; it < SEQ * G_DK; it += c.NT) {
        const int t = it >> 10, cc = it & 1023; float x = bg[cc];
#pragma unroll
        for (int r = 0; r < 16; ++r) x += GL[t * 16 + r] * w2[r * G_DK + cc];
        const float ls = -softplus(-x);
        AG[it] = __expf(ls * (1.f / 16.f));
    }
}
__device__ __forceinline__ void gla_scan_naive(const Ctx& c, const bf16* QKVR, const float* AG, float* OG) {
    for (int item = c.gw; item < G_H * G_HV; item += c.NGW) {
        const int h = item >> 9, v = item & 511;
        float S0 = 0.f, S1 = 0.f, S2 = 0.f, S3 = 0.f;
        const float* ap = AG + h * G_HK + 4 * c.lane; const bf16* qp = QKVR + h * G_HK + 4 * c.lane; const bf16* kp = QKVR + G_DK + h * G_HK + 4 * c.lane; const bf16* vp = QKVR + 2 * G_DK + h * G_HV + v;
        for (int t0 = 0; t0 < SEQ; t0 += 4) {
            f32x4 a4[4]; v2u k4[4], q4[4]; float vv[4];
#pragma unroll
            for (int j = 0; j < 4; ++j) { const size_t t = t0 + j; a4[j] = *(const f32x4*)(ap + t * G_DK); k4[j] = *(const v2u*)(kp + t * G_QKVR); q4[j] = *(const v2u*)(qp + t * G_QKVR); vv[j] = bf2f(vp[t * G_QKVR]); }
#pragma unroll
            for (int j = 0; j < 4; ++j) {
                S0 = S0 * a4[j].x + bf_lo(k4[j].x) * vv[j]; S1 = S1 * a4[j].y + bf_hi(k4[j].x) * vv[j]; S2 = S2 * a4[j].z + bf_lo(k4[j].y) * vv[j]; S3 = S3 * a4[j].w + bf_hi(k4[j].y) * vv[j];
                const float o = wave_sum((bf_lo(q4[j].x) * S0 + bf_hi(q4[j].x) * S1) + (bf_lo(q4[j].y) * S2 + bf_hi(q4[j].y) * S3)) * (1.f / 16.f);
                if (c.lane == 0) OG[(size_t)(t0 + j) * G_DV + h * G_HV + v] = o; }
        }
    }
}
__device__ __forceinline__ void gla_outnorm(const Ctx& c, const float* OG, const bf16* QKVR, const float* nw, bf16* MIX) {
    for (int it = c.gw; it < SEQ * G_H; it += c.NGW) {
        const int t = it >> 2, h = it & 3; const size_t off = (size_t)it * 512 + 8 * c.lane;
        const f32x4 a = *(const f32x4*)(OG + off), b = *(const f32x4*)(OG + off + 4);
        const float ss = (a.x * a.x + a.y * a.y) + (a.z * a.z + a.w * a.w) + (b.x * b.x + b.y * b.y) + (b.z * b.z + b.w * b.w);
        const float rs = rsqrtf(wave_sum(ss) * (1.f / 512.f) + EPS);
        const f32x4 wa = *(const f32x4*)(nw + 8 * c.lane), wb = *(const f32x4*)(nw + 8 * c.lane + 4);
        const v4u r = *(const v4u*)(QKVR + (size_t)t * G_QKVR + 2 * G_DK + G_DV + h * G_HV + 8 * c.lane);
        v4u o; o.x = pk2(a.x * rs * wa.x * silu(bf_lo(r.x)), a.y * rs * wa.y * silu(bf_hi(r.x))); o.y = pk2(a.z * rs * wa.z * silu(bf_lo(r.y)), a.w * rs * wa.w * silu(bf_hi(r.y)));
        o.z = pk2(b.x * rs * wb.x * silu(bf_lo(r.z)), b.y * rs * wb.y * silu(bf_hi(r.z))); o.w = pk2(b.z * rs * wb.z * silu(bf_lo(r.w)), b.w * rs * wb.w * silu(bf_hi(r.w)));
        *(v4u*)(MIX + off) = o;
    }
}

__device__ __forceinline__ void sgu_rstd(const Ctx& c, const bf16* ZZ, float* RS) {
    for (int t = c.gw; t < SEQ; t += c.NGW) {
        const v4u* p = (const v4u*)(ZZ + (size_t)t * 8192 + U_W) + c.lane; float s = 0.f;
#pragma unroll
        for (int j = 0; j < 8; ++j) { const v4u x = p[64 * j]; const unsigned w[4] = {x.x, x.y, x.z, x.w};
#pragma unroll
            for (int i = 0; i < 4; ++i) { const float lo = bf_lo(w[i]), hi = bf_hi(w[i]); s += lo * lo + hi * hi; } }
        s = wave_sum(s);
        if (c.lane == 0) RS[t] = rsqrtf(s * (1.f / U_W) + EPS);
    }
}
__device__ __forceinline__ void sgu_mix_naive(const Ctx& c, const bf16* ZZ, const float* RS, const float* WS, const float* BS, const float* nw, bf16* MIX) {
    for (int it = c.gw; it < SEQ * U_G; it += c.NGW) {
        const int g = it & 7, t = it >> 3, c0 = t & ~127, tt = t & 127;
        float acc[8];
#pragma unroll
        for (int j = 0; j < 8; ++j) acc[j] = 0.f;
        const float* wrow = WS + (size_t)g * 16384 + tt * 128;
        for (int s = 0; s <= tt; ++s) { const float w = wrow[s] * RS[c0 + s];
            const v4u x = *(const v4u*)(ZZ + (size_t)(c0 + s) * 8192 + U_W + g * 512 + 8 * c.lane); const unsigned xw[4] = {x.x, x.y, x.z, x.w};
#pragma unroll
            for (int j = 0; j < 4; ++j) { acc[2 * j] += w * bf_lo(xw[j]); acc[2 * j + 1] += w * bf_hi(xw[j]); } }
        const v4u uu = *(const v4u*)(ZZ + (size_t)t * 8192 + g * 512 + 8 * c.lane); const unsigned uw[4] = {uu.x, uu.y, uu.z, uu.w};
        const float b = BS[g * 128 + tt]; const float* nwp = nw + g * 512 + 8 * c.lane;
        v4u o; unsigned ow[4];
#pragma unroll
        for (int j = 0; j < 4; ++j) ow[j] = pk2(bf_lo(uw[j]) * (acc[2 * j] * nwp[2 * j] + b), bf_hi(uw[j]) * (acc[2 * j + 1] * nwp[2 * j + 1] + b));
        o.x = ow[0]; o.y = ow[1]; o.z = ow[2]; o.w = ow[3];
        *(v4u*)(MIX + (size_t)t * U_W + g * 512 + 8 * c.lane) = o;
    }
}
constexpr int NPH = 74, PH_FINAL = 73;
enum { KIND_SSD = 0, KIND_GLA = 1, KIND_SGU = 2, KIND_FFN = 3 };
__host__ __device__ inline int step_kind(int s) { return (s % 3 == 1) ? ((s / 3) % 3) : KIND_FFN; }
__host__ __device__ inline bool slot_used(int k) {
    if (k == 0 || k == PH_FINAL) return true;
    const int s = (k - 1) / 6, j = (k - 1) % 6, kind = step_kind(s);
    if (kind == KIND_FFN) return j <= 1 || j == 5;
    if (kind == KIND_SGU) return j != 4;
    return true;
}
__device__ __forceinline__ int opaque_idx(int i) { asm volatile("" : "+s"(i)); return i; }
struct Args { const float* in[25]; float* out; unsigned char* ws; int ph_lo, ph_hi; };

__global__ void __launch_bounds__(NWAVES * 64, 2) mk_fwd(Args args) {
    extern __shared__ __attribute__((aligned(16))) unsigned char lds_raw[];
    LAS unsigned char* lds = (LAS unsigned char*)lds_raw;
    volatile LAS unsigned* MISC = (volatile LAS unsigned*)(lds + MISC_OFF);
    Ctx c0; c0.tid = threadIdx.x; c0.lane = c0.tid & 63; c0.wave = __builtin_amdgcn_readfirstlane(c0.tid >> 6);
    c0.G = gridDim.x; { const int bx = blockIdx.x; c0.vcu = (c0.G % 8 == 0) ? (bx % 8) * (c0.G / 8) + bx / 8 : bx; }
    c0.gw = c0.vcu * NWAVES + c0.wave; c0.NGW = c0.G * NWAVES; c0.gtid = c0.vcu * (NWAVES * 64) + c0.tid; c0.NT = c0.G * NWAVES * 64;
    unsigned char* ws = args.ws;
    unsigned* ctl = (unsigned*)(ws + WS_CTL);
    for (int u = c0.tid; u < (LDS_BYTES - LDSCTL_OFF) / 4; u += NWAVES * 64) ((LAS unsigned*)(lds + LDSCTL_OFF))[u] = 0u;
    __syncthreads();
    const int lo = args.ph_lo, hi = args.ph_hi;
    const bool fused = (hi - lo) > 1;
    XcdBarrier bar; bar.bar = ctl + CW_BAR; bar.x = 0; bar.st = nullptr;
    if (fused) bar = xcd_barrier_post(ctl + CW_BAR, MISC + 8);
#define IN(k) (lo <= (k) && (k) < hi)
#define SEAM() do { if (fused) xcd_barrier(bar); } while (0)
#define FRESH() Ctx c = c0; asm volatile("" : "+v"(c.tid), "+v"(c.lane), "+v"(c.gtid)); asm volatile("" : "+s"(c.gw), "+s"(c.NGW), "+s"(c.NT))
#define INP(i) (args.in[opaque_idx(i)])

    float* H = (float*)(ws + WS_H); bf16* HN = (bf16*)(ws + WS_HN); bf16* BIG = (bf16*)(ws + WS_BIG); bf16* MIX = (bf16*)(ws + WS_MIX);
    unsigned char* scr = ws + WS_SCR;

    if (IN(0)) {
        FRESH();
        LAS float* tscr = (LAS float*)(lds + RING_OFF + c.wave * 16384);
        for (int i = 0; i < 8; ++i) {
            convert_matrix<1>(c, tscr, INP(2) + (size_t)i * DM * 2 * DFF, DM, 2 * DFF, 2 * DFF, (bf16*)(ws + WS_W_FFN_IN + i * SZ_FFN_IN));
            convert_matrix<0>(c, tscr, INP(3) + (size_t)i * DFF * DM, DFF, DM, DM, (bf16*)(ws + WS_W_FFN_OUT + i * SZ_FFN_OUT));
        }
        for (int i = 0; i < 2; ++i) {
            convert_matrix<0>(c, tscr, INP(5) + (size_t)i * DM * S_IN, DM, S_IN, S_INP, (bf16*)(ws + WS_W_SSD_IN + i * SZ_SSD_IN));
            convert_matrix<0>(c, tscr, INP(12) + (size_t)i * S_DI * DM, S_DI, DM, DM, (bf16*)(ws + WS_W_SSD_OUT + i * SZ_SSD_OUT));
        }
        convert_matrix<0>(c, tscr, INP(13), DM, G_IN, G_INP, (bf16*)(ws + WS_W_GLA_IN));
        convert_matrix<0>(c, tscr, INP(17), G_DV, DM, DM, (bf16*)(ws + WS_W_GLA_OUT));
        convert_matrix<0>(c, tscr, INP(18), DM, 2 * U_W, 2 * U_W, (bf16*)(ws + WS_W_SGU_IN));
        convert_matrix<0>(c, tscr, INP(23), U_W, DM, DM, (bf16*)(ws + WS_W_SGU_OUT));
        { const f32x4* src = (const f32x4*)INP(0); f32x4* dst = (f32x4*)H;
          for (int i = c.gtid; i < SEQ * DM / 4; i += c.NT) dst[i] = src[i]; }
        SEAM();
    }

    for (int s = 0; s < 3 * DEPTH; ++s) {
        const int base = 1 + 6 * s, layer = s / 3, sub = s % 3, kind = step_kind(s), mj = layer / 3, fi = layer * 2 + (sub >> 1);
        if (IN(base)) {
            FRESH();
            const float* gain = (sub == 1) ? INP(4) + (size_t)layer * DM : INP(1) + (size_t)fi * DM;
            rmsnorm_rows<true>(c, H, gain, HN);
            SEAM();
        }
        if (IN(base + 1)) {
            if (kind == KIND_FFN) {
                pg8::Gemm g{HN, (const bf16*)(ws + WS_W_FFN_IN + fi * SZ_FFN_IN), SEQ, 2 * DFF, DM}; pg8::StaticOrder S; S.init(SEQ, 2 * DFF, c0.G, (int)blockIdx.x);
                pg8::EpiSwiGLU E{BIG, DFF};
                pg8::gemm_phase<pg8::EpiSwiGLU, pg8::StaticOrder, true, true>(lds + RING_OFF, g, S, E);
            } else {
                const bf16* W = (const bf16*)(ws + (kind == KIND_SSD ? WS_W_SSD_IN + mj * SZ_SSD_IN : kind == KIND_GLA ? WS_W_GLA_IN : WS_W_SGU_IN));
                const int Np = kind == KIND_SSD ? S_INP : kind == KIND_GLA ? G_INP : 2 * U_W, ldo = kind == KIND_SSD ? S_ZX : kind == KIND_GLA ? G_QKVR : 2 * U_W;
                pg8::Gemm g{HN, W, SEQ, Np, DM}; pg8::StaticOrder S; S.init(SEQ, Np, c0.G, (int)blockIdx.x);
                pg8::EpiBf16X E{BIG, ldo, kind == KIND_SGU ? INP(19) : nullptr, ldo / 256, (float*)(scr + (kind == KIND_SSD ? SC_DTR : SC_GL)), kind == KIND_SSD ? 64 : 16};
                pg8::gemm_phase<pg8::EpiBf16X, pg8::StaticOrder, true, true>(lds + RING_OFF, g, S, E);
            }
            SEAM();
        }
        if (kind == KIND_SSD) {
            bf16* XC = (bf16*)(scr + SC_XC); float* DTR = (float*)(scr + SC_DTR); float* DT = (float*)(scr + SC_DT); float* YG = (float*)(scr + SC_YG);
            if (IN(base + 2)) { FRESH(); ssd_conv_dt(c, BIG, INP(6) + (size_t)mj * S_CONVD * 4, INP(7) + (size_t)mj * S_CONVD, DTR, INP(8) + mj * 64, XC, DT); SEAM(); }
            if (IN(base + 3)) { FRESH(); ssd_scan_naive(c, XC, BIG, DT, INP(9) + mj * 64, INP(10) + mj * 64, YG); SEAM(); }
            if (IN(base + 4)) { FRESH(); ssd_groupnorm(c, YG, INP(11) + (size_t)mj * S_DI, MIX); SEAM(); }
        } else if (kind == KIND_GLA) {
            float* GL = (float*)(scr + SC_GL); float* AG = (float*)(scr + SC_AG); float* OG = (float*)(scr + SC_OG);
            if (IN(base + 2)) { FRESH(); gla_gate(c, GL, INP(14), INP(15), AG); SEAM(); }
            if (IN(base + 3)) { FRESH(); gla_scan_naive(c, BIG, AG, OG); SEAM(); }
            if (IN(base + 4)) { FRESH(); gla_outnorm(c, OG, BIG, INP(16), MIX); SEAM(); }
        } else if (kind == KIND_SGU) {
            float* RS = (float*)(scr + SC_RS);
            if (IN(base + 2)) { FRESH(); sgu_rstd(c, BIG, RS); SEAM(); }
            if (IN(base + 3)) { FRESH(); sgu_mix_naive(c, BIG, RS, INP(21), INP(22), INP(20), MIX); SEAM(); }
        }
        if (IN(base + 5)) {
            const bf16* A = kind == KIND_FFN ? BIG : MIX;
            const bf16* W = (const bf16*)(ws + (kind == KIND_FFN ? WS_W_FFN_OUT + fi * SZ_FFN_OUT : kind == KIND_SSD ? WS_W_SSD_OUT + mj * SZ_SSD_OUT : kind == KIND_GLA ? WS_W_GLA_OUT : WS_W_SGU_OUT));
            const int K = kind == KIND_FFN ? DFF : kind == KIND_GLA ? G_DV : 4096;
            pg8::Gemm g{A, W, SEQ, DM, K}; pg8::StaticOrder S; S.init(SEQ, DM, c0.G, (int)blockIdx.x);
            pg8::EpiResid E{H, DM, kind == KIND_FFN ? 0.5f : 1.0f};
            pg8::gemm_phase<pg8::EpiResid, pg8::StaticOrder, true, true>(lds + RING_OFF, g, S, E);
            SEAM();
        }
    }
    if (IN(PH_FINAL)) { FRESH(); rmsnorm_rows<false>(c, H, INP(24), args.out); }
#undef IN
#undef SEAM
#undef FRESH
#undef INP
}

extern "C" void kernel_launch(void* const* d_in, const int* in_sizes, int n_in, void* d_out, int out_size, void* d_ws, size_t ws_size, hipStream_t stream) {
    static int grid = 0;
    if (grid == 0) {
        if (n_in != 25 || out_size != SEQ * DM || ws_size < WS_END) { fprintf(stderr, "kernel_launch: unexpected problem (n_in %d, out %d, ws %zu < %zu)\n", n_in, out_size, ws_size, (size_t)WS_END); grid = -1; return; }
        int dev = 0, cus = 0, per_cu = 0;
        if (hipGetDevice(&dev) != hipSuccess || hipDeviceGetAttribute(&cus, hipDeviceAttributeMultiprocessorCount, dev) != hipSuccess) { grid = -1; return; }
        if (hipFuncSetAttribute((const void*)mk_fwd, hipFuncAttributeMaxDynamicSharedMemorySize, LDS_BYTES) != hipSuccess) { fprintf(stderr, "kernel_launch: hipFuncSetAttribute failed\n"); grid = -1; return; }
        if (hipOccupancyMaxActiveBlocksPerMultiprocessor(&per_cu, (const void*)mk_fwd, NWAVES * 64, LDS_BYTES) != hipSuccess || per_cu < 1) fprintf(stderr, "kernel_launch: occupancy query reports %d\n", per_cu);
        (void)hipGetLastError();
        grid = cus;
    }
    if (grid < 0) return;
    if (hipMemsetAsync((char*)d_ws + WS_CTL, 0, CTL_ZERO_BYTES, stream) != hipSuccess) return;
    Args a{};
    for (int i = 0; i < 25; ++i) a.in[i] = (const float*)d_in[i];
    a.out = (float*)d_out; a.ws = (unsigned char*)d_ws;
#if MK_PER_PHASE
    for (int k = 0; k < NPH; ++k) { if (!slot_used(k)) continue; a.ph_lo = k; a.ph_hi = k + 1;
        hipLaunchKernelGGL(mk_fwd, dim3(grid), dim3(NWAVES * 64), LDS_BYTES, stream, a); }
#else
    a.ph_lo = 0; a.ph_hi = NPH;
    hipLaunchKernelGGL(mk_fwd, dim3(grid), dim3(NWAVES * 64), LDS_BYTES, stream, a);
#endif
    const hipError_t le = hipPeekAtLastError();
    if (le != hipSuccess) fprintf(stderr, "kernel_launch: launch failed: %s\n", hipGetErrorName(le));
}
```

```cpp
#include <hip/hip_runtime.h>
#include <cstdio>
#include <cstdint>
#ifndef MK_PER_PHASE
#define MK_PER_PHASE 0
#endif
#undef MK_PER_PHASE
#define MK_PER_PHASE 0
namespace pg8 {
#define PG8_LAS __attribute__((address_space(3)))
typedef unsigned short bf16_t;
typedef short bf16x8 __attribute__((ext_vector_type(8)));
typedef float f32x4 __attribute__((ext_vector_type(4)));
typedef unsigned u32x4 __attribute__((ext_vector_type(4)));
constexpr int BM = 256, BK = 64, HALF = 128, HTB = HALF * BK * 2  , STAGE_BYTES = 8 * HTB, NXCD = 8, WGM = 8;

__host__ __device__ __forceinline__ int lds_byte(int r, int c) { const int st = (r >> 4) * 2 + (c >> 5), rr = r & 15, cc = c & 31, ob = rr * 64 + cc * 2; return st * 1024 + (ob ^ (((ob >> 9) & 1) << 5)); }
__host__ __device__ __forceinline__ void stage_rc(int b, int& R, int& C) { const int st = b / 1024, sb = b % 1024, swz = sb ^ (((sb >> 9) & 1) << 5); R = (st >> 1) * 16 + swz / 64; C = (st & 1) * 32 + (swz % 64) / 2; }
__host__ __device__ __forceinline__ int perm32(int rho) { const int n = rho >> 4, i = rho & 15; return 8 * (i >> 2) + 4 * n + (i & 3); }

struct Unit { int pm, pn; };
struct Gemm { const bf16_t* A; const bf16_t* Bt; int M, N, K; };

struct StaticOrder {
    int nM, nN, nwg, G, c;
    __host__ __device__ void init(int M, int N, int G_, int c_) { nM = M / BM; nN = N / BM; nwg = nM * nN; G = G_; c = c_; }
    __host__ __device__ bool next(int i, Unit& u) const {
        const long L = (long)i * G + c; if (L >= nwg) return false;
        int wgid = (int)L; { const int q = nwg / NXCD, r = nwg % NXCD, xcd = wgid % NXCD, off = wgid / NXCD; wgid = (xcd < r ? xcd * (q + 1) : r * (q + 1) + (xcd - r) * q) + off; }
        const int nig = WGM * nN, gid = wgid / nig, fm = gid * WGM, gsz = (nM - fm) < WGM ? (nM - fm) : WGM;
        u.pm = fm + ((wgid % nig) % gsz); u.pn = (wgid % nig) / gsz; return true;
    }
    __device__ __forceinline__ void a_ready(const Unit&) const {}
    __device__ __forceinline__ void done(const Unit&) const {}
};
__device__ __forceinline__ unsigned cvt_pk_bf16(float lo, float hi) { unsigned r; asm volatile("v_cvt_pk_bf16_f32 %0, %1, %2" : "=v"(r) : "v"(lo), "v"(hi)); return r; }
typedef float f32x2 __attribute__((ext_vector_type(2)));
__device__ __forceinline__ f32x2 gelu_pk(f32x2 v) {
    const f32x2 av = __builtin_elementwise_abs(v), d = av * 0.2316418882f + 1.0f;
    f32x2 t; t.x = __builtin_amdgcn_rcpf(d.x); t.y = __builtin_amdgcn_rcpf(d.y);
    f32x2 q = t * 0.5307027145f + (-0.7265760135f); q = q * t + 0.7107068705f; q = q * t + (-0.142248368f); q = q * t + 0.127414796f; q = q * t;
    const f32x2 s = (v * v) * (-0.72134752044f);
    f32x2 e; e.x = __builtin_amdgcn_exp2f(s.x); e.y = __builtin_amdgcn_exp2f(s.y);
    const f32x2 m = v * (q * e), r = v - m;
    f32x2 o; o.x = v.x < 0.f ? m.x : r.x; o.y = v.y < 0.f ? m.y : r.y; return o;
}
__device__ __forceinline__ float silu_f(float x) { return x / (1.0f + __expf(-x)); }
__device__ __forceinline__ u32x4 pack8(const f32x4 v0, const f32x4 v1) { u32x4 w; w.x = cvt_pk_bf16(v0[0], v0[1]); w.y = cvt_pk_bf16(v0[2], v0[3]); w.z = cvt_pk_bf16(v1[0], v1[1]); w.w = cvt_pk_bf16(v1[2], v1[3]); return w; }

struct EpiSwiGLU {
    static constexpr bool PERM = true, AFTER_DRAIN = false;
    bf16_t* O; int ldc;
    __device__ __forceinline__ void operator()(const f32x4 (&acc)[2][2][4][2], const Unit& u, int wr, int wc, int fr, int fq) const {
        const int row0 = u.pm * BM + wr * 64 + fr, col0 = u.pn * HALF + wc * 32 + 8 * fq;
#pragma unroll
        for (int ai = 0; ai < 2; ++ai)
#pragma unroll
            for (int m = 0; m < 4; ++m) { bf16_t* rowp = O + (size_t)(row0 + ai * HALF + m * 16) * ldc + col0;
                f32x4 o0, o1;
#pragma unroll
                for (int i = 0; i < 4; ++i) { o0[i] = silu_f(acc[ai][0][m][0][i]) * acc[ai][1][m][0][i]; o1[i] = silu_f(acc[ai][0][m][1][i]) * acc[ai][1][m][1][i]; }
                *(u32x4*)rowp = pack8(o0, o1); }
    }
};
struct EpiResid {
    static constexpr bool PERM = false, AFTER_DRAIN = false;
    float* H; int ldc; float scale;
    __device__ __forceinline__ void operator()(const f32x4 (&acc)[2][2][4][2], const Unit& u, int wr, int wc, int fr, int fq) const {
        const int row0 = u.pm * BM + wr * 64 + fr, col0 = u.pn * BM + wc * 32 + 4 * fq;
#pragma unroll
        for (int ai = 0; ai < 2; ++ai)
#pragma unroll
            for (int m = 0; m < 4; ++m) { float* rowp = H + (size_t)(row0 + ai * HALF + m * 16) * ldc + col0;
#pragma unroll
                for (int bj = 0; bj < 2; ++bj)
#pragma unroll
                    for (int n = 0; n < 2; ++n) { f32x4* p = (f32x4*)(rowp + bj * HALF + n * 16); *p = *p + acc[ai][bj][m][n] * scale; } }
    }
};
struct EpiBf16X {
    static constexpr bool PERM = true, AFTER_DRAIN = false;
    bf16_t* O; int ldc; const float* bias; int npn_main; float* X; int nx;
    __device__ __forceinline__ void operator()(const f32x4 (&acc)[2][2][4][2], const Unit& u, int wr, int wc, int fr, int fq) const {
        const int row0 = u.pm * BM + wr * 64 + fr;
        if (u.pn < npn_main) {
            const int col0 = u.pn * BM + wc * 32 + 8 * fq;
            f32x4 bv[2][2];
#pragma unroll
            for (int bj = 0; bj < 2; ++bj)
#pragma unroll
                for (int n = 0; n < 2; ++n) bv[bj][n] = bias ? *(const f32x4*)(bias + col0 + bj * HALF + 4 * n) : (f32x4){0.f, 0.f, 0.f, 0.f};
#pragma unroll
            for (int ai = 0; ai < 2; ++ai)
#pragma unroll
                for (int m = 0; m < 4; ++m) { bf16_t* rowp = O + (size_t)(row0 + ai * HALF + m * 16) * ldc + col0;
#pragma unroll
                    for (int bj = 0; bj < 2; ++bj) { f32x4 v0 = acc[ai][bj][m][0] + bv[bj][0], v1 = acc[ai][bj][m][1] + bv[bj][1];
                        if (bias) { f32x2 a = gelu_pk((f32x2){v0[0], v0[1]}), b = gelu_pk((f32x2){v0[2], v0[3]}), c = gelu_pk((f32x2){v1[0], v1[1]}), d = gelu_pk((f32x2){v1[2], v1[3]});
                            v0 = (f32x4){a.x, a.y, b.x, b.y}; v1 = (f32x4){c.x, c.y, d.x, d.y}; }
                        *(u32x4*)(rowp + bj * HALF) = pack8(v0, v1); } }
        } else {
            const int c0 = wc * 32 + 8 * fq;
            if (c0 < nx) {
#pragma unroll
                for (int ai = 0; ai < 2; ++ai)
#pragma unroll
                    for (int m = 0; m < 4; ++m) { float* rowp = X + (size_t)(row0 + ai * HALF + m * 16) * nx + c0;
                        *(f32x4*)rowp = acc[ai][0][m][0]; *(f32x4*)(rowp + 4) = acc[ai][0][m][1]; }
            }
        }
    }
};
template <class Epi, class Sched, bool ALIGN_EPI = false, bool SP2 = false>
__device__ __forceinline__ void gemm_phase(PG8_LAS unsigned char* lds, const Gemm g, const Sched& S, const Epi& E) {
    int tid_ = threadIdx.x; asm volatile("" : "+v"(tid_));
    const int tid = tid_, wid = __builtin_amdgcn_readfirstlane(tid >> 6), lane = tid & 63, wr = wid >> 2, wc = wid & 3, fr = lane & 15, fq = lane >> 4;
    const int K = g.K, nt = K / BK;
    unsigned voffA[2], voffB[2];
#pragma unroll
    for (int i = 0; i < 2; ++i) { int R, C; stage_rc(tid * 16 + i * 8192, R, C); const int Rb = Epi::PERM ? ((R & ~31) + perm32(R & 31)) : R;
        voffA[i] = (unsigned)(R * K + C) * 2u; voffB[i] = (unsigned)(Rb * K + C) * 2u; }
    const size_t kstep = (size_t)(BK * 2);
    const size_t hstep = (size_t)HALF * K * 2;
    const size_t tstep = 2 * hstep;
    const unsigned ldsw = (unsigned)wid * 1024u;
    const int aoff = lds_byte(wr * 64 + fr, fq * 8), boff = lds_byte(wc * 32 + fr, fq * 8);
#define PG8_SA(b, h) (((b) * 2 + (h)) * HTB)
#define PG8_SB(b, h) ((4 + (b) * 2 + (h)) * HTB)
#define PG8_STAGE(bufoff, gbase, voff) do { _Pragma("unroll") for (int _i = 0; _i < 2; ++_i) \
        __builtin_amdgcn_global_load_lds((const unsigned*)((const char*)(gbase) + (voff)[_i]), (PG8_LAS unsigned*)(lds + (bufoff) + ldsw + _i * 8192), 16, 0, 0); } while (0)
#define PG8_LDA(dst, b, h) do { _Pragma("unroll") for (int m = 0; m < 4; ++m) _Pragma("unroll") for (int k = 0; k < 2; ++k) dst[m][k] = *(const PG8_LAS bf16x8*)(lds + PG8_SA(b, h) + aoff + m * 2048 + k * 1024); } while (0)
#define PG8_LDB(dst, b, h) do { _Pragma("unroll") for (int n = 0; n < 2; ++n) _Pragma("unroll") for (int k = 0; k < 2; ++k) dst[n][k] = *(const PG8_LAS bf16x8*)(lds + PG8_SB(b, h) + boff + n * 2048 + k * 1024); } while (0)
#define PG8_MMA(ai, bj, At, Bt) do { __builtin_amdgcn_s_setprio(1); _Pragma("unroll") for (int m = 0; m < 4; ++m) _Pragma("unroll") for (int n = 0; n < 2; ++n) _Pragma("unroll") for (int k = 0; k < 2; ++k) \
        acc[ai][bj][m][n] = __builtin_amdgcn_mfma_f32_16x16x32_bf16(Bt[n][k], At[m][k], acc[ai][bj][m][n], 0, 0, 0); __builtin_amdgcn_s_setprio(0); } while (0)
#define PG8_WAIT_V(n) asm volatile("s_waitcnt vmcnt(" #n ")" ::: "memory")
#define PG8_WAIT_L(n) asm volatile("s_waitcnt lgkmcnt(" #n ")" ::: "memory")
#define PG8_BAR __builtin_amdgcn_s_barrier()
#define PG8_SCHED __builtin_amdgcn_sched_barrier(0)
    Unit cur, nxt; int ui = 0;
    if (!S.next(0, cur)) return;
    f32x4 acc[2][2][4][2];
#pragma unroll
    for (int a = 0; a < 2; ++a)
#pragma unroll
        for (int b = 0; b < 2; ++b)
#pragma unroll
            for (int m = 0; m < 4; ++m)
#pragma unroll
                for (int n = 0; n < 2; ++n) acc[a][b][m][n] = (f32x4){0.f, 0.f, 0.f, 0.f};
    bf16x8 At[4][2], B0[2][2], B1[2][2];
    const char* cA = (const char*)g.A + (size_t)cur.pm * tstep; const char* cB = (const char*)g.Bt + (size_t)cur.pn * tstep;
    S.a_ready(cur);
    if constexpr (SP2) {
        PG8_STAGE(PG8_SB(0, 0), cB, voffB); PG8_STAGE(PG8_SB(0, 1), cB + hstep, voffB); PG8_STAGE(PG8_SA(0, 0), cA, voffA); PG8_STAGE(PG8_SA(0, 1), cA + hstep, voffA);
        if (wr == 1) PG8_BAR;
        PG8_WAIT_V(2); PG8_BAR;
        PG8_STAGE(PG8_SB(1, 0), cB + kstep, voffB); PG8_STAGE(PG8_SA(1, 0), cA + kstep, voffA); PG8_STAGE(PG8_SB(1, 1), cB + hstep + kstep, voffB);
        PG8_WAIT_V(6); PG8_BAR;
    } else {
        PG8_STAGE(PG8_SB(0, 0), cB, voffB); PG8_STAGE(PG8_SA(0, 0), cA, voffA); PG8_STAGE(PG8_SB(0, 1), cB + hstep, voffB); PG8_STAGE(PG8_SA(0, 1), cA + hstep, voffA);
        if (wr == 1) PG8_BAR;
        PG8_WAIT_V(4); PG8_BAR;
        PG8_STAGE(PG8_SB(1, 0), cB + kstep, voffB); PG8_STAGE(PG8_SA(1, 0), cA + kstep, voffA); PG8_STAGE(PG8_SB(1, 1), cB + hstep + kstep, voffB);
        PG8_WAIT_V(6); PG8_BAR;
    }
    for (;;) {
        const bool has_next = S.next(ui + 1, nxt);
        const char* nA = has_next ? (const char*)g.A + (size_t)nxt.pm * tstep : cA; const char* nB = has_next ? (const char*)g.Bt + (size_t)nxt.pn * tstep : cB;
        for (int t = 0; t < nt; t += 2) {
            const bool last = (t == nt - 2);
            const char* a1 = cA + (size_t)(t + 1) * kstep;
            const char* a2 = last ? nA : cA + (size_t)(t + 2) * kstep; const char* b2 = last ? nB : cB + (size_t)(t + 2) * kstep;
            const char* a3 = a2 + kstep; const char* b3 = b2 + kstep;
            if (last && has_next) S.a_ready(nxt);
            if constexpr (SP2) {
            PG8_LDB(B0, 0, 0); PG8_LDB(B1, 0, 1); PG8_SCHED; PG8_LDA(At, 0, 0); PG8_STAGE(PG8_SA(1, 1), a1 + hstep, voffA);
            PG8_WAIT_V(8); PG8_WAIT_L(0); PG8_BAR; PG8_MMA(0, 0, At, B0); PG8_MMA(0, 1, At, B1); PG8_BAR; PG8_SCHED;
            PG8_LDA(At, 0, 1); PG8_STAGE(PG8_SB(0, 0), b2, voffB); PG8_STAGE(PG8_SB(0, 1), b2 + hstep, voffB); PG8_STAGE(PG8_SA(0, 0), a2, voffA);
            PG8_WAIT_V(8); PG8_WAIT_L(0); PG8_BAR; PG8_MMA(1, 0, At, B0); PG8_MMA(1, 1, At, B1); PG8_BAR; PG8_SCHED;
            PG8_LDB(B0, 1, 0); PG8_LDB(B1, 1, 1); PG8_SCHED; PG8_LDA(At, 1, 0); PG8_STAGE(PG8_SA(0, 1), a2 + hstep, voffA);
            PG8_WAIT_V(8); PG8_WAIT_L(0); PG8_BAR; PG8_MMA(0, 0, At, B0); PG8_MMA(0, 1, At, B1); PG8_BAR; PG8_SCHED;
            PG8_LDA(At, 1, 1); PG8_STAGE(PG8_SB(1, 0), b3, voffB); PG8_STAGE(PG8_SB(1, 1), b3 + hstep, voffB); PG8_STAGE(PG8_SA(1, 0), a3, voffA);
            PG8_WAIT_V(8); PG8_WAIT_L(0); PG8_BAR; PG8_MMA(1, 0, At, B0); PG8_MMA(1, 1, At, B1); PG8_BAR; PG8_SCHED;
            } else {
            PG8_LDB(B0, 0, 0); PG8_SCHED; PG8_LDA(At, 0, 0); PG8_STAGE(PG8_SA(1, 1), a1 + hstep, voffA);
            PG8_WAIT_L(8); PG8_BAR; PG8_WAIT_L(0); PG8_MMA(0, 0, At, B0); PG8_BAR; PG8_SCHED;
            PG8_LDB(B1, 0, 1); PG8_STAGE(PG8_SB(0, 0), b2, voffB);
            PG8_BAR; PG8_WAIT_L(0); PG8_MMA(0, 1, At, B1); PG8_BAR;
            PG8_LDA(At, 0, 1); PG8_STAGE(PG8_SA(0, 0), a2, voffA);
            PG8_BAR; PG8_WAIT_L(0); PG8_MMA(1, 0, At, B0); PG8_BAR; PG8_SCHED;
            PG8_STAGE(PG8_SB(0, 1), b2 + hstep, voffB);
            PG8_WAIT_V(6); PG8_BAR; PG8_MMA(1, 1, At, B1); PG8_BAR;
            PG8_LDB(B0, 1, 0); PG8_SCHED; PG8_LDA(At, 1, 0); PG8_STAGE(PG8_SA(0, 1), a2 + hstep, voffA);
            PG8_WAIT_L(8); PG8_BAR; PG8_WAIT_L(0); PG8_MMA(0, 0, At, B0); PG8_BAR; PG8_SCHED;
            PG8_LDB(B1, 1, 1); PG8_STAGE(PG8_SB(1, 0), b3, voffB);
            PG8_BAR; PG8_WAIT_L(0); PG8_MMA(0, 1, At, B1); PG8_BAR;
            PG8_LDA(At, 1, 1); PG8_STAGE(PG8_SA(1, 0), a3, voffA);
            PG8_BAR; PG8_WAIT_L(0); PG8_MMA(1, 0, At, B0); PG8_BAR; PG8_SCHED;
            PG8_STAGE(PG8_SB(1, 1), b3 + hstep, voffB);
            PG8_WAIT_V(6); PG8_BAR; PG8_MMA(1, 1, At, B1); PG8_BAR;
            }
        }
        if constexpr (ALIGN_EPI) { if (wr == 0) PG8_BAR; }
        if constexpr (!Epi::AFTER_DRAIN) { E(acc, cur, wr, wc, fr, fq); S.done(cur); }
        if (!has_next) break;
#pragma unroll
        for (int a = 0; a < 2; ++a)
#pragma unroll
            for (int b = 0; b < 2; ++b)
#pragma unroll
                for (int m = 0; m < 4; ++m)
#pragma unroll
                    for (int n = 0; n < 2; ++n) acc[a][b][m][n] = (f32x4){0.f, 0.f, 0.f, 0.f};
        cur = nxt; cA = nA; cB = nB; ++ui;
        if constexpr (ALIGN_EPI) { if (wr == 1) PG8_BAR; }
    }
    PG8_WAIT_V(0);
    if constexpr (!ALIGN_EPI) { if (wr == 0) PG8_BAR; }
    PG8_BAR;
    if constexpr (Epi::AFTER_DRAIN) { E.fused(acc, cur, wr, wc, fr, fq, lds, wid, lane); S.done(cur); }
#undef PG8_SA
#undef PG8_SB
#undef PG8_STAGE
#undef PG8_LDA
#undef PG8_LDB
#undef PG8_MMA
#undef PG8_WAIT_V
#undef PG8_WAIT_L
#undef PG8_BAR
#undef PG8_SCHED
}
}
constexpr int SEQ = 8192, DM = 2048, DFF = 5632, DEPTH = 4, NWAVES = 8;
constexpr float EPS = 1e-6f;
constexpr int S_DI = 4096, S_NH = 64, S_P = 64, S_G = 8, S_N = 128, S_CONVD = 6144, S_IN = 10304, S_INP = 10496, S_ZX = 10240;
constexpr int G_H = 4, G_DK = 1024, G_DV = 2048, G_HK = 256, G_HV = 512, G_R = 16, G_IN = 6160, G_INP = 6400, G_QKVR = 6144;
constexpr int U_W = 4096, U_G = 8, U_GD = 512, U_Q = 128;

constexpr size_t MiB = 1u << 20;
constexpr size_t WS_CTL = 0, CTL_ZERO_BYTES = 1 * MiB;
constexpr size_t SZ_FFN_IN = (size_t)2 * DFF * DM * 2, SZ_FFN_OUT = (size_t)DM * DFF * 2;
constexpr size_t SZ_SSD_IN = (size_t)S_INP * DM * 2, SZ_SSD_OUT = (size_t)DM * S_DI * 2;
constexpr size_t WS_W_FFN_IN = 1 * MiB;
constexpr size_t WS_W_FFN_OUT = WS_W_FFN_IN + 8 * SZ_FFN_IN;
constexpr size_t WS_W_SSD_IN = WS_W_FFN_OUT + 8 * SZ_FFN_OUT;
constexpr size_t WS_W_SSD_OUT = WS_W_SSD_IN + 2 * SZ_SSD_IN;
constexpr size_t WS_W_GLA_IN = WS_W_SSD_OUT + 2 * SZ_SSD_OUT;
constexpr size_t WS_W_GLA_OUT = WS_W_GLA_IN + (size_t)G_INP * DM * 2;
constexpr size_t WS_W_SGU_IN = WS_W_GLA_OUT + (size_t)DM * G_DV * 2;
constexpr size_t WS_W_SGU_OUT = WS_W_SGU_IN + (size_t)2 * U_W * DM * 2;
constexpr size_t WS_W_END = WS_W_SGU_OUT + (size_t)DM * U_W * 2;
constexpr size_t WS_H = (WS_W_END + MiB - 1) / MiB * MiB;
constexpr size_t WS_HN = WS_H + (size_t)SEQ * DM * 4;
constexpr size_t WS_BIG = WS_HN + (size_t)SEQ * DM * 2;
constexpr size_t WS_MIX = WS_BIG + (size_t)SEQ * S_ZX * 2;
constexpr size_t WS_SCR = WS_MIX + (size_t)SEQ * 4096 * 2;
constexpr size_t WS_SCR_BYTES = 512 * MiB;
constexpr size_t WS_END = WS_SCR + WS_SCR_BYTES;
static_assert(WS_H % 256 == 0 && WS_W_SSD_IN % 256 == 0 && WS_W_GLA_IN % 256 == 0, "alignment");
constexpr size_t SC_XC = 0;
constexpr size_t SC_DTR = SC_XC + (size_t)SEQ * S_CONVD * 2;
constexpr size_t SC_DT = SC_DTR + (size_t)SEQ * 64 * 4;
constexpr size_t SC_ST = SC_DT + (size_t)SEQ * 64 * 4;
constexpr size_t SC_PV = SC_ST + (size_t)64 * 64 * 64 * 128 * 4;
constexpr size_t SC_CD = SC_PV + (size_t)64 * 64 * 64 * 128 * 2;
constexpr size_t SC_SSD_END = SC_CD + 64 * 64 * 4;
constexpr size_t SC_GL = 0;
constexpr size_t SC_BC = SC_GL + (size_t)SEQ * 16 * 4;
constexpr size_t SC_KV = SC_BC + (size_t)SEQ * 1024 * 4;
constexpr size_t SC_SP = SC_KV + (size_t)128 * 4 * 512 * 256 * 4;
constexpr size_t SC_GLA_END = SC_SP + (size_t)128 * 4 * 512 * 256 * 2;
constexpr size_t SC_RS = 0;
static_assert(SC_SSD_END <= WS_SCR_BYTES && SC_GLA_END <= WS_SCR_BYTES, "scratch map");
constexpr int CW_BAR = 4096;

constexpr int RING_OFF = 0, RING_BYTES = 131072;
constexpr int LDS_BYTES = 163840;
constexpr int LDSCTL_OFF = LDS_BYTES - 1024, MISC_OFF = LDSCTL_OFF + 320;

#define GAS __attribute__((address_space(1)))
#define LAS __attribute__((address_space(3)))
typedef unsigned short bf16;
typedef unsigned v4u __attribute__((ext_vector_type(4)));
typedef unsigned v2u __attribute__((ext_vector_type(2)));
typedef float f32x4 __attribute__((ext_vector_type(4)));
#define LDS_WAIT() asm volatile("s_waitcnt lgkmcnt(0)" ::: "memory")
__device__ __forceinline__ unsigned f2bf(float f) { unsigned u = __builtin_bit_cast(unsigned, f); return (u + 0x7fffu + ((u >> 16) & 1u)) >> 16; }
__device__ __forceinline__ unsigned pk2(float lo, float hi) { return f2bf(lo) | (f2bf(hi) << 16); }
__device__ __forceinline__ float bf_lo(unsigned w) { return __builtin_bit_cast(float, w << 16); }
__device__ __forceinline__ float bf_hi(unsigned w) { return __builtin_bit_cast(float, w & 0xffff0000u); }
__device__ __forceinline__ float bf2f(bf16 b) { return __builtin_bit_cast(float, (unsigned)b << 16); }
__device__ __forceinline__ float silu(float x) { return x / (1.0f + __expf(-x)); }
__device__ __forceinline__ float softplus(float x) { return x > 20.f ? x : log1pf(__expf(x)); }
__device__ __forceinline__ float wave_sum(float v) {
#pragma unroll
    for (int o = 1; o < 64; o <<= 1) v += __shfl_xor(v, o);
    return v;
}
#define XB_TMO      128
#define XB_XCNT(j)  (256  + 64 * (j))
#define XB_XSUB(j)  (1280 + 64 * (j))
#define XB_XGEN(j)  (2304 + 64 * (j))
#define XB_TOP      3328
#define XB_TOPGEN   3392
#define XCD_BAR_WORDS 3456
#define XB_SPIN_CAP (1u << 18)

__device__ __forceinline__ unsigned xb_ld(unsigned* p)              { return __hip_atomic_load(p, __ATOMIC_RELAXED, __HIP_MEMORY_SCOPE_AGENT); }
__device__ __forceinline__ unsigned xb_add(unsigned* p, unsigned v) { return __hip_atomic_fetch_add(p, v, __ATOMIC_RELAXED, __HIP_MEMORY_SCOPE_AGENT); }
__device__ __forceinline__ unsigned xb_xcc_id() { return (unsigned)__builtin_amdgcn_s_getreg((3 << 11) | 20) & 0xFu; }
#define XB_SPIN(cond, bar) do { unsigned _sp = 0; while (cond) { __builtin_amdgcn_s_sleep(1); \
    if ((++_sp & 255u) == 0u) { if (xb_ld(&(bar)[XB_TMO])) break; if (_sp > XB_SPIN_CAP) { atomicAdd(&(bar)[XB_TMO], 1u); break; } } } } while (0)

struct XcdBarrier {
    unsigned* bar; unsigned x;
    volatile LAS unsigned* st;
};

__device__ __forceinline__ XcdBarrier xcd_barrier_post(unsigned* bar, volatile LAS unsigned* st) {
    XcdBarrier b; b.bar = bar; b.x = xb_xcc_id(); b.st = st;
    if (threadIdx.x == 0) (void)xb_add(&bar[XB_XCNT(b.x)], 1u);
    return b;
}
__device__ __forceinline__ void xcd_barrier_complete(unsigned* bar, unsigned x, unsigned& nloc, unsigned& nx) {
    const unsigned G = gridDim.x * gridDim.y * gridDim.z;
    unsigned sum, cnt, mine, sp = 0u;
    for (;;) {
        sum = 0u; cnt = 0u; mine = 0u;
#pragma unroll
        for (unsigned j = 0; j < 16; ++j) { const unsigned c = xb_ld(&bar[XB_XCNT(j)]); sum += c; cnt += (c > 0u) ? 1u : 0u; mine = (j == x) ? c : mine; }
        if (sum == G) break;
        __builtin_amdgcn_s_sleep(1);
        if ((++sp & 255u) == 0u) { if (xb_ld(&bar[XB_TMO])) break; if (sp > XB_SPIN_CAP) { atomicAdd(&bar[XB_TMO], 1u); break; } }
    }
    nloc = mine > 0u ? mine : 1u; nx = cnt > 0u ? cnt : 1u;
}

__device__ __forceinline__ void xcd_barrier(const XcdBarrier& b) {
    asm volatile("s_waitcnt vmcnt(0)" ::: "memory");
    __syncthreads();
    if (threadIdx.x == 0) {
        unsigned* bar = b.bar;
        __builtin_amdgcn_s_waitcnt(0);
        unsigned nloc = b.st[0], nx = b.st[1];
        if (nloc == 0u) { xcd_barrier_complete(bar, b.x, nloc, nx); b.st[0] = nloc; b.st[1] = nx; }
        const unsigned old = xb_add(&bar[XB_XSUB(b.x)], 1u);
        const unsigned gen = old / nloc;
        if (old + 1u == (gen + 1u) * nloc) {
            __builtin_amdgcn_fence(__ATOMIC_RELEASE, "agent");
            asm volatile("s_waitcnt vmcnt(0)" ::: "memory");
            const unsigned og = xb_add(&bar[XB_TOP], 1u);
            const unsigned tg = og / nx;
            if (og + 1u == (tg + 1u) * nx) xb_add(&bar[XB_TOPGEN], 1u);
            else XB_SPIN(xb_ld(&bar[XB_TOPGEN]) == tg, bar);
            __builtin_amdgcn_fence(__ATOMIC_ACQUIRE, "agent");
            xb_add(&bar[XB_XGEN(b.x)], 1u);
            asm volatile("s_waitcnt vmcnt(0)" ::: "memory");
        } else {
            XB_SPIN(xb_ld(&bar[XB_XGEN(b.x)]) == gen, bar);
            __builtin_amdgcn_fence(__ATOMIC_ACQUIRE, "agent");
            asm volatile("s_waitcnt vmcnt(0)" ::: "memory");
        }
    }
    __syncthreads();
}

struct Ctx { int tid, lane, wave, G, vcu, gw, NGW, gtid, NT; };

__device__ __forceinline__ void tr_item(const float* W, int K, int Nsrc, int n0, int k0, bf16* WT, int d0, LAS float* scr, int lane) {
    const int n = n0 + (lane & 31); const bool ok = n < Nsrc;
#pragma unroll 8
    for (int i = 0; i < 32; ++i) { const int kk = 2 * i + (lane >> 5); scr[kk * 33 + (lane & 31)] = ok ? W[(size_t)(k0 + kk) * Nsrc + n] : 0.f; }
    LDS_WAIT(); asm volatile("" ::: "memory");
    const int c = lane & 7;
#pragma unroll
    for (int j = 0; j < 4; ++j) { const int nn = (lane >> 3) + 8 * j; const LAS float* s = scr + (8 * c) * 33 + nn;
        v4u o; o.x = pk2(s[0 * 33], s[1 * 33]); o.y = pk2(s[2 * 33], s[3 * 33]); o.z = pk2(s[4 * 33], s[5 * 33]); o.w = pk2(s[6 * 33], s[7 * 33]);
        *(v4u*)(WT + (size_t)(d0 + nn) * K + k0 + 8 * c) = o; }
    LDS_WAIT(); asm volatile("" ::: "memory");
}
template <int MODE> __device__ __forceinline__ void convert_matrix(const Ctx& c, LAS float* scr, const float* W, int K, int Nsrc, int Ndst, bf16* WT) {
    const int nblk = Ndst / 32, nitems = (K / 64) * nblk;
    for (int it = c.gw; it < nitems; it += c.NGW) {
        const int kb = it / nblk, nb = it % nblk, d0 = 32 * nb;
        int n0 = d0;
        if (MODE == 1) { const int pn = d0 >> 8, bj = (d0 >> 7) & 1, j0 = d0 & 127; n0 = bj * DFF + 128 * pn + j0; }
        tr_item(W, K, Nsrc, n0, 64 * kb, WT, d0, scr, c.lane);
    }
}

template <bool OUT_BF16> __device__ __forceinline__ void rmsnorm_rows(const Ctx& c, const float* X, const float* gain, void* out) {
    for (int m = c.gw; m < SEQ; m += c.NGW) {
        const f32x4* xr = (const f32x4*)(X + (size_t)m * DM) + c.lane;
        f32x4 v[8]; float s = 0.f;
#pragma unroll
        for (int j = 0; j < 8; ++j) { v[j] = xr[64 * j]; s += (v[j].x * v[j].x + v[j].y * v[j].y) + (v[j].z * v[j].z + v[j].w * v[j].w); }
        const float rs = rsqrtf(wave_sum(s) * (1.f / DM) + EPS);
        const f32x4* gr = (const f32x4*)gain + c.lane;
#pragma unroll
        for (int j = 0; j < 8; ++j) { const f32x4 g = gr[64 * j]; const f32x4 o = v[j] * rs * g;
            if (OUT_BF16) { v2u w; w.x = pk2(o.x, o.y); w.y = pk2(o.z, o.w); *((v2u*)((bf16*)out + (size_t)m * DM) + c.lane + 64 * j) = w; }
            else *((f32x4*)((float*)out + (size_t)m * DM) + c.lane + 64 * j) = o; }
    }
}

__device__ __forceinline__ void ssd_conv_dt(const Ctx& c, const bf16* ZX, const float* cw, const float* cb, const float* DTR, const float* dtb, bf16* XC, float* DT) {
    constexpr int NV = S_CONVD / 8;
    for (int it = c.gtid; it < SEQ * NV; it += c.NT) {
        const int t = it / NV, ch = (it % NV) * 8;
        float a[8];
#pragma unroll
        for (int j = 0; j < 8; ++j) a[j] = cb[ch + j];
#pragma unroll
        for (int k = 0; k < 4; ++k) { const int ts = t - 3 + k;
            if (ts >= 0) { const v4u x = *(const v4u*)(ZX + (size_t)ts * S_ZX + S_DI + ch);
                const unsigned xw[4] = {x.x, x.y, x.z, x.w};
#pragma unroll
                for (int j = 0; j < 4; ++j) { a[2 * j] += bf_lo(xw[j]) * cw[(ch + 2 * j) * 4 + k]; a[2 * j + 1] += bf_hi(xw[j]) * cw[(ch + 2 * j + 1) * 4 + k]; } } }
        v4u o; o.x = pk2(silu(a[0]), silu(a[1])); o.y = pk2(silu(a[2]), silu(a[3])); o.z = pk2(silu(a[4]), silu(a[5])); o.w = pk2(silu(a[6]), silu(a[7]));
        *(v4u*)(XC + (size_t)t * S_CONVD + ch) = o;
    }
    for (int it = c.gtid; it < SEQ * 64; it += c.NT) DT[it] = softplus(DTR[it] + dtb[it & 63]);
}
__device__ __forceinline__ void ssd_scan_naive(const Ctx& c, const bf16* XC, const bf16* ZX, const float* DT, const float* a_log, const float* dskip, float* YG) {
    for (int item = c.gw; item < S_NH * S_P; item += c.NGW) {
        const int h = item >> 6, p = item & 63, g = h >> 3;
        const float a = -__expf(a_log[h]), Dh = dskip[h];
        float s0 = 0.f, s1 = 0.f;
        const bf16* xcol = XC + h * 64 + p; const bf16* bcol = XC + S_DI + g * S_N + 2 * c.lane; const bf16* ccol = XC + S_DI + S_G * S_N + g * S_N + 2 * c.lane;
        const bf16* zcol = ZX + h * 64 + p; const float* dtp = DT + h;
        for (int t0 = 0; t0 < SEQ; t0 += 8) {
            float dtv[8], xv[8], zv[8]; unsigned bb[8], cc[8];
#pragma unroll
            for (int j = 0; j < 8; ++j) { const size_t t = t0 + j; dtv[j] = dtp[t * 64]; xv[j] = bf2f(xcol[t * S_CONVD]); zv[j] = bf2f(zcol[t * S_ZX]);
                bb[j] = *(const unsigned*)(bcol + t * S_CONVD); cc[j] = *(const unsigned*)(ccol + t * S_CONVD); }
#pragma unroll
            for (int j = 0; j < 8; ++j) { const float dA = __expf(dtv[j] * a), xd = dtv[j] * xv[j];
                s0 = s0 * dA + xd * bf_lo(bb[j]); s1 = s1 * dA + xd * bf_hi(bb[j]);
                const float y = wave_sum(bf_lo(cc[j]) * s0 + bf_hi(cc[j]) * s1) + Dh * xv[j];
                if (c.lane == 0) YG[(size_t)(t0 + j) * S_DI + h * 64 + p] = y * silu(zv[j]); }
        }
    }
}
__device__ __forceinline__ void ssd_groupnorm(const Ctx& c, const float* YG, const float* nw, bf16* MIX) {
    for (int it = c.gw; it < SEQ * S_G; it += c.NGW) {
        const size_t off = (size_t)it * 512 + 8 * c.lane; const int col = (it & 7) * 512 + 8 * c.lane;
        const f32x4 a = *(const f32x4*)(YG + off), b = *(const f32x4*)(YG + off + 4);
        const float ss = (a.x * a.x + a.y * a.y) + (a.z * a.z + a.w * a.w) + (b.x * b.x + b.y * b.y) + (b.z * b.z + b.w * b.w);
        const float rs = rsqrtf(wave_sum(ss) * (1.f / 512.f) + EPS);
        const f32x4 wa = *(const f32x4*)(nw + col), wb = *(const f32x4*)(nw + col + 4);
        v4u o; o.x = pk2(a.x * rs * wa.x, a.y * rs * wa.y); o.y = pk2(a.z * rs * wa.z, a.w * rs * wa.w); o.z = pk2(b.x * rs * wb.x, b.y * rs * wb.y); o.w = pk2(b.z * rs * wb.z, b.w * rs * wb.w);
        *(v4u*)(MIX + off) = o;
    }
}

__device__ __forceinline__ void gla_gate(const Ctx& c, const float* GL, const float* w2, const float* bg, float* AG) {
    for (int it = c.gtid; it < SEQ * G_DK; it += c.NT) {
        const int t = it >> 10, cc = it & 1023; float x = bg[cc];
#pragma unroll
        for (int r = 0; r < 16; ++r) x += GL[t * 16 + r] * w2[r * G_DK + cc];
        const float ls = -softplus(-x);
        AG[it] = __expf(ls * (1.f / 16.f));
    }
}
__device__ __forceinline__ void gla_scan_naive(const Ctx& c, const bf16* QKVR, const float* AG, float* OG) {
    for (int item = c.gw; item < G_H * G_HV; item += c.NGW) {
        const int h = item >> 9, v = item & 511;
        float S0 = 0.f, S1 = 0.f, S2 = 0.f, S3 = 0.f;
        const float* ap = AG + h * G_HK + 4 * c.lane; const bf16* qp = QKVR + h * G_HK + 4 * c.lane; const bf16* kp = QKVR + G_DK + h * G_HK + 4 * c.lane; const bf16* vp = QKVR + 2 * G_DK + h * G_HV + v;
        for (int t0 = 0; t0 < SEQ; t0 += 4) {
            f32x4 a4[4]; v2u k4[4], q4[4]; float vv[4];
#pragma unroll
            for (int j = 0; j < 4; ++j) { const size_t t = t0 + j; a4[j] = *(const f32x4*)(ap + t * G_DK); k4[j] = *(const v2u*)(kp + t * G_QKVR); q4[j] = *(const v2u*)(qp + t * G_QKVR); vv[j] = bf2f(vp[t * G_QKVR]); }
#pragma unroll
            for (int j = 0; j < 4; ++j) {
                S0 = S0 * a4[j].x + bf_lo(k4[j].x) * vv[j]; S1 = S1 * a4[j].y + bf_hi(k4[j].x) * vv[j]; S2 = S2 * a4[j].z + bf_lo(k4[j].y) * vv[j]; S3 = S3 * a4[j].w + bf_hi(k4[j].y) * vv[j];
                const float o = wave_sum((bf_lo(q4[j].x) * S0 + bf_hi(q4[j].x) * S1) + (bf_lo(q4[j].y) * S2 + bf_hi(q4[j].y) * S3)) * (1.f / 16.f);
                if (c.lane == 0) OG[(size_t)(t0 + j) * G_DV + h * G_HV + v] = o; }
        }
    }
}
__device__ __forceinline__ void gla_outnorm(const Ctx& c, const float* OG, const bf16* QKVR, const float* nw, bf16* MIX) {
    for (int it = c.gw; it < SEQ * G_H; it += c.NGW) {
        const int t = it >> 2, h = it & 3; const size_t off = (size_t)it * 512 + 8 * c.lane;
        const f32x4 a = *(const f32x4*)(OG + off), b = *(const f32x4*)(OG + off + 4);
        const float ss = (a.x * a.x + a.y * a.y) + (a.z * a.z + a.w * a.w) + (b.x * b.x + b.y * b.y) + (b.z * b.z + b.w * b.w);
        const float rs = rsqrtf(wave_sum(ss) * (1.f / 512.f) + EPS);
        const f32x4 wa = *(const f32x4*)(nw + 8 * c.lane), wb = *(const f32x4*)(nw + 8 * c.lane + 4);
        const v4u r = *(const v4u*)(QKVR + (size_t)t * G_QKVR + 2 * G_DK + G_DV + h * G_HV + 8 * c.lane);
        v4u o; o.x = pk2(a.x * rs * wa.x * silu(bf_lo(r.x)), a.y * rs * wa.y * silu(bf_hi(r.x))); o.y = pk2(a.z * rs * wa.z * silu(bf_lo(r.y)), a.w * rs * wa.w * silu(bf_hi(r.y)));
        o.z = pk2(b.x * rs * wb.x * silu(bf_lo(r.z)), b.y * rs * wb.y * silu(bf_hi(r.z))); o.w = pk2(b.z * rs * wb.z * silu(bf_lo(r.w)), b.w * rs * wb.w * silu(bf_hi(r.w)));
        *(v4u*)(MIX + off) = o;
    }
}

__device__ __forceinline__ void sgu_rstd(const Ctx& c, const bf16* ZZ, float* RS) {
    for (int t = c.gw; t < SEQ; t += c.NGW) {
        const v4u* p = (const v4u*)(ZZ + (size_t)t * 8192 + U_W) + c.lane; float s = 0.f;
#pragma unroll
        for (int j = 0; j < 8; ++j) { const v4u x = p[64 * j]; const unsigned w[4] = {x.x, x.y, x.z, x.w};
#pragma unroll
            for (int i = 0; i < 4; ++i) { const float lo = bf_lo(w[i]), hi = bf_hi(w[i]); s += lo * lo + hi * hi; } }
        s = wave_sum(s);
        if (c.lane == 0) RS[t] = rsqrtf(s * (1.f / U_W) + EPS);
    }
}
__device__ __forceinline__ void sgu_mix_naive(const Ctx& c, const bf16* ZZ, const float* RS, const float* WS, const float* BS, const float* nw, bf16* MIX) {
    for (int it = c.gw; it < SEQ * U_G; it += c.NGW) {
        const int g = it & 7, t = it >> 3, c0 = t & ~127, tt = t & 127;
        float acc[8];
#pragma unroll
        for (int j = 0; j < 8; ++j) acc[j] = 0.f;
        const float* wrow = WS + (size_t)g * 16384 + tt * 128;
        for (int s = 0; s <= tt; ++s) { const float w = wrow[s] * RS[c0 + s];
            const v4u x = *(const v4u*)(ZZ + (size_t)(c0 + s) * 8192 + U_W + g * 512 + 8 * c.lane); const unsigned xw[4] = {x.x, x.y, x.z, x.w};
#pragma unroll
            for (int j = 0; j < 4; ++j) { acc[2 * j] += w * bf_lo(xw[j]); acc[2 * j + 1] += w * bf_hi(xw[j]); } }
        const v4u uu = *(const v4u*)(ZZ + (size_t)t * 8192 + g * 512 + 8 * c.lane); const unsigned uw[4] = {uu.x, uu.y, uu.z, uu.w};
        const float b = BS[g * 128 + tt]; const float* nwp = nw + g * 512 + 8 * c.lane;
        v4u o; unsigned ow[4];
#pragma unroll
        for (int j = 0; j < 4; ++j) ow[j] = pk2(bf_lo(uw[j]) * (acc[2 * j] * nwp[2 * j] + b), bf_hi(uw[j]) * (acc[2 * j + 1] * nwp[2 * j + 1] + b));
        o.x = ow[0]; o.y = ow[1]; o.z = ow[2]; o.w = ow[3];
        *(v4u*)(MIX + (size_t)t * U_W + g * 512 + 8 * c.lane) = o;
    }
}
typedef short bf16x8 __attribute__((ext_vector_type(8)));
typedef short s16x4 __attribute__((ext_vector_type(4)));
#define MFMA16(a, b, c) __builtin_amdgcn_mfma_f32_16x16x32_bf16((a), (b), (c), 0, 0, 0)
__device__ __forceinline__ bf16x8 frag_rm(const LAS unsigned char* base, int pitch, int r0, int k0, int lane) {
    return *(const LAS bf16x8*)(base + (r0 + (lane & 15)) * pitch + (k0 + 8 * (lane >> 4)) * 2);
}
__device__ __forceinline__ bf16x8 frag_tr(const LAS unsigned char* base, int pitch, int k0, int c0, int lane) {
    const int g = lane >> 4, q = (lane & 15) >> 2, p = lane & 3;
    const LAS unsigned char* a = base + (k0 + 8 * g + q) * pitch + (c0 + 4 * p) * 2;
    const s16x4 lo = __builtin_amdgcn_ds_read_tr16_b64_v4i16((LAS s16x4*)a);
    const s16x4 hi = __builtin_amdgcn_ds_read_tr16_b64_v4i16((LAS s16x4*)(a + 4 * pitch));
    return (bf16x8){lo[0], lo[1], lo[2], lo[3], hi[0], hi[1], hi[2], hi[3]};
}
__device__ __forceinline__ bf16x8 frag_gl(const bf16* T, size_t ld, int c0, int k0, int lane) {
    return *(const bf16x8*)(T + (size_t)(c0 + (lane & 15)) * ld + k0 + 8 * (lane >> 4));
}
constexpr int QT_PITCH = 144, QT_BYTES = 32 * QT_PITCH;
__device__ __forceinline__ void stage_qtile(LAS unsigned char* xt, const bf16* src, size_t ld, int lane) {
    v4u x[4];
#pragma unroll
    for (int i = 0; i < 4; ++i) x[i] = *(const v4u*)(src + (size_t)((lane >> 3) + 8 * i) * ld + 8 * (lane & 7));
#pragma unroll
    for (int i = 0; i < 4; ++i) *(LAS v4u*)(xt + ((lane >> 3) + 8 * i) * QT_PITCH + 16 * (lane & 7)) = x[i];
}

__device__ __forceinline__ int opaque_v(int x) { asm volatile("" : "+v"(x)); return x; }

__device__ __forceinline__ void sgu_mix(const Ctx& c_, LAS unsigned char* lds, const bf16* ZZ, const float* RS, const float* WS, const float* BS, const float* nw, bf16* MIX) {
    constexpr int WP = 272;
    LAS unsigned char* Wt = lds; LAS unsigned char* xt = lds + 128 * WP + c_.wave * QT_BYTES;
    for (int unit = c_.vcu; unit < (SEQ / U_Q) * U_G; unit += c_.G) {
        const int g = unit & 7, t0 = (unit >> 3) * U_Q;
        Ctx c = c_; c.lane = opaque_v(c_.lane); c.tid = opaque_v(c_.tid);
        for (int it = c.tid; it < 128 * 16; it += NWAVES * 64) {
            const int t = it >> 4, s8 = (it & 15) * 8;
            const f32x4 w0 = *(const f32x4*)(WS + (size_t)g * 16384 + t * 128 + s8), w1 = *(const f32x4*)(WS + (size_t)g * 16384 + t * 128 + s8 + 4);
            const f32x4 r0 = *(const f32x4*)(RS + t0 + s8), r1 = *(const f32x4*)(RS + t0 + s8 + 4);
            float v[8] = {w0.x * r0.x, w0.y * r0.y, w0.z * r0.z, w0.w * r0.w, w1.x * r1.x, w1.y * r1.y, w1.z * r1.z, w1.w * r1.w};
#pragma unroll
            for (int j = 0; j < 8; ++j) v[j] = (s8 + j <= t) ? v[j] : 0.f;
            v4u o; o.x = pk2(v[0], v[1]); o.y = pk2(v[2], v[3]); o.z = pk2(v[4], v[5]); o.w = pk2(v[6], v[7]);
            *(LAS v4u*)(Wt + t * WP + s8 * 2) = o;
        }
        __syncthreads();
        const int d0 = g * U_GD + c.wave * 64;
        f32x4 acc[8][4];
#pragma unroll
        for (int a = 0; a < 8; ++a)
#pragma unroll
            for (int b = 0; b < 4; ++b) acc[a][b] = (f32x4){0.f, 0.f, 0.f, 0.f};
#pragma unroll
        for (int ks = 0; ks < 4; ++ks) {
            stage_qtile(xt, ZZ + (size_t)(t0 + 32 * ks) * (2 * U_W) + U_W + d0, 2 * U_W, c.lane);
            bf16x8 bfr[4];
#pragma unroll
            for (int dt = 0; dt < 4; ++dt) bfr[dt] = frag_tr(xt, QT_PITCH, 0, 16 * dt, c.lane);
#pragma unroll
            for (int tt = 2 * ks; tt < 8; ++tt) {
                const bf16x8 a = frag_rm(Wt, WP, 16 * tt, 32 * ks, c.lane);
#pragma unroll
                for (int dt = 0; dt < 4; ++dt) acc[tt][dt] = MFMA16(a, bfr[dt], acc[tt][dt]);
            }
        }
        const int gq = c.lane >> 4, r = c.lane & 15;
#pragma unroll
        for (int tt = 0; tt < 8; ++tt)
#pragma unroll
            for (int i = 0; i < 4; ++i) { const int tl = 16 * tt + 4 * gq + i; const size_t t = t0 + tl; const float b = BS[g * 128 + tl];
#pragma unroll
                for (int dt = 0; dt < 4; ++dt) { const int col = d0 + 16 * dt + r;
                    const float u = bf2f(ZZ[t * (2 * U_W) + col]);
                    MIX[t * U_W + col] = (bf16)f2bf(u * (acc[tt][dt][i] * nw[col] + b)); } }
        __syncthreads();
    }
}
__device__ __forceinline__ float wave_incl_scan(float x, int lane) {
#pragma unroll
    for (int o = 1; o < 64; o <<= 1) { const float n = __shfl_up(x, o); if (lane >= o) x += n; }
    return x;
}
__device__ __forceinline__ float ssd_dt_acum(const float* DT, const float* a_log, int t0, int h, int lane, LAS float* AC, LAS float* DTL) {
    const float a = -__expf(a_log[h]);
    const float d0 = DT[(size_t)(t0 + 2 * lane) * 64 + h], d1 = DT[(size_t)(t0 + 2 * lane + 1) * 64 + h];
    const float e0 = d0 * a, e1 = d1 * a;
    const float incl = wave_incl_scan(e0 + e1, lane);
    AC[2 * lane] = incl - e1; AC[2 * lane + 1] = incl; DTL[2 * lane] = d0; DTL[2 * lane + 1] = d1;
    return __shfl(incl, 63);
}
constexpr int SS_TP = 272, SS_TILE = 128 * SS_TP;

__device__ __forceinline__ void ssd_states(const Ctx& c_, LAS unsigned char* lds, const bf16* XC, const float* DT, const float* a_log, float* ST, float* CD) {
    LAS unsigned char* Bt = lds; LAS unsigned char* xt = lds + SS_TILE + c_.wave * QT_BYTES;
    LAS float* AC = (LAS float*)(lds + SS_TILE + 8 * QT_BYTES + c_.wave * 1024); LAS float* DTL = AC + 128;
    for (int unit = c_.vcu; unit < (SEQ / 128) * S_G; unit += c_.G) {
        Ctx c = c_; c.lane = opaque_v(c_.lane); c.tid = opaque_v(c_.tid);
        const int g = unit & 7, cc = unit >> 3, t0 = cc * 128, h = g * 8 + c.wave;
        for (int it = c.tid; it < 128 * 16; it += NWAVES * 64) { const int row = it >> 4, ch = it & 15;
            *(LAS v4u*)(Bt + row * SS_TP + ch * 16) = *(const v4u*)(XC + (size_t)(t0 + row) * S_CONVD + S_DI + g * S_N + ch * 8); }
        const float aend = ssd_dt_acum(DT, a_log, t0, h, c.lane, AC, DTL);
        if (c.lane == 0) CD[cc * 64 + h] = __expf(aend);
        __syncthreads();
        f32x4 acc[4][8];
#pragma unroll
        for (int a = 0; a < 4; ++a)
#pragma unroll
            for (int b = 0; b < 8; ++b) acc[a][b] = (f32x4){0.f, 0.f, 0.f, 0.f};
#pragma unroll
        for (int ks = 0; ks < 4; ++ks) {
            {
                v4u x[4];
#pragma unroll
                for (int i = 0; i < 4; ++i) x[i] = *(const v4u*)(XC + (size_t)(t0 + 32 * ks + (c.lane >> 3) + 8 * i) * S_CONVD + h * 64 + 8 * (c.lane & 7));
#pragma unroll
                for (int i = 0; i < 4; ++i) { const int s = 32 * ks + (c.lane >> 3) + 8 * i; const float w = DTL[s] * __expf(aend - AC[s]);
                    v4u o; o.x = pk2(bf_lo(x[i].x) * w, bf_hi(x[i].x) * w); o.y = pk2(bf_lo(x[i].y) * w, bf_hi(x[i].y) * w); o.z = pk2(bf_lo(x[i].z) * w, bf_hi(x[i].z) * w); o.w = pk2(bf_lo(x[i].w) * w, bf_hi(x[i].w) * w);
                    *(LAS v4u*)(xt + ((c.lane >> 3) + 8 * i) * QT_PITCH + 16 * (c.lane & 7)) = o; }
            }
            bf16x8 afr[4];
#pragma unroll
            for (int pt = 0; pt < 4; ++pt) afr[pt] = frag_tr(xt, QT_PITCH, 0, 16 * pt, c.lane);
#pragma unroll
            for (int nt = 0; nt < 8; ++nt) { const bf16x8 b = frag_tr(Bt, SS_TP, 32 * ks, 16 * nt, c.lane);
#pragma unroll
                for (int pt = 0; pt < 4; ++pt) acc[pt][nt] = MFMA16(afr[pt], b, acc[pt][nt]); }
        }
        float* stb = ST + ((size_t)(cc * 64 + h) * 64) * 128;
        const int gq = c.lane >> 4, r = c.lane & 15;
#pragma unroll
        for (int pt = 0; pt < 4; ++pt)
#pragma unroll
            for (int i = 0; i < 4; ++i)
#pragma unroll
                for (int nt = 0; nt < 8; ++nt) { stb[(16 * pt + 4 * gq + i) * 128 + 16 * nt + r] = acc[pt][nt][i]; if (nt == 7) asm volatile("" ::: "memory"); }
        __syncthreads();
    }
}
__device__ __forceinline__ void ssd_chunk_scan(const Ctx& c, const float* ST, const float* CD, bf16* PV) {
    constexpr int NV = 64 * 64 * 128 / 4, CS = 64 * 64 * 128;
    for (int idx = c.gtid; idx < NV; idx += c.NT) {
        const int h = idx >> 11; f32x4 st = (f32x4){0.f, 0.f, 0.f, 0.f};
        for (int c0 = 0; c0 < 64; c0 += 8) {
            f32x4 s[8]; float d[8];
#pragma unroll
            for (int j = 0; j < 8; ++j) { s[j] = *(const f32x4*)(ST + (size_t)(c0 + j) * CS + (size_t)idx * 4); d[j] = CD[(c0 + j) * 64 + h]; }
#pragma unroll
            for (int j = 0; j < 8; ++j) { v2u o; o.x = pk2(st.x, st.y); o.y = pk2(st.z, st.w); *(v2u*)(PV + (size_t)(c0 + j) * CS + (size_t)idx * 4) = o; st = st * d[j] + s[j]; }
        }
    }
}
__device__ __forceinline__ void ssd_out(const Ctx& c_, LAS unsigned char* lds, const bf16* XC, const bf16* ZX, const float* DT, const float* a_log, const float* dskip, const bf16* PV, const float* nw, bf16* MIX) {
    LAS unsigned char* Ct = lds; LAS unsigned char* Bt = lds + SS_TILE; LAS unsigned char* xt = lds + 2 * SS_TILE + c_.wave * QT_BYTES;
    LAS float* AC = (LAS float*)(lds + 2 * SS_TILE + 8 * QT_BYTES + c_.wave * 1024); LAS float* DTL = AC + 128;
    LAS float* RSS = (LAS float*)(lds + 2 * SS_TILE + 8 * QT_BYTES + 8 * 1024);
    for (int unit = c_.vcu; unit < (SEQ / 128) * S_G; unit += c_.G) {
        Ctx c = c_; c.lane = opaque_v(c_.lane); c.tid = opaque_v(c_.tid);
        const int gq = c.lane >> 4, r = c.lane & 15;
        const int g = unit & 7, cc = unit >> 3, t0 = cc * 128, h = g * 8 + c.wave;
        for (int it = c.tid; it < 128 * 16; it += NWAVES * 64) { const int row = it >> 4, ch = it & 15; const bf16* src = XC + (size_t)(t0 + row) * S_CONVD + S_DI + g * S_N + ch * 8;
            *(LAS v4u*)(Bt + row * SS_TP + ch * 16) = *(const v4u*)src; *(LAS v4u*)(Ct + row * SS_TP + ch * 16) = *(const v4u*)(src + S_G * S_N); }
        (void)ssd_dt_acum(DT, a_log, t0, h, c.lane, AC, DTL);
        const float Dh = dskip[h];
        __syncthreads();
        {
            f32x4 cb[8];
#pragma unroll
            for (int st = 0; st < 8; ++st) cb[st] = (f32x4){0.f, 0.f, 0.f, 0.f};
#pragma unroll
            for (int ks = 0; ks < 4; ++ks) { const bf16x8 a = frag_rm(Ct, SS_TP, 16 * c.wave, 32 * ks, c.lane);
#pragma unroll
                for (int st = 0; st < 8; ++st) if (st <= c.wave) { const bf16x8 b = frag_rm(Bt, SS_TP, 16 * st, 32 * ks, c.lane); cb[st] = MFMA16(a, b, cb[st]); } }
            __syncthreads();
#pragma unroll
            for (int st = 0; st < 8; ++st) if (st <= c.wave) {
#pragma unroll
                for (int i = 0; i < 4; ++i) *(LAS bf16*)(Bt + (16 * c.wave + 4 * gq + i) * SS_TP + (16 * st + r) * 2) = (bf16)f2bf(cb[st][i]); }
            __syncthreads();
        }
#pragma unroll 1
        for (int hb = 0; hb < 2; ++hb) {
        Ctx c = c_; c.lane = opaque_v(c_.lane);
        const int gq = c.lane >> 4, r = c.lane & 15;
        f32x4 acc[4][4];
#pragma unroll
        for (int a = 0; a < 4; ++a)
#pragma unroll
            for (int b = 0; b < 4; ++b) acc[a][b] = (f32x4){0.f, 0.f, 0.f, 0.f};
        {
            const bf16* pvb = PV + ((size_t)(cc * 64 + h) * 64) * 128;
#pragma unroll
            for (int ks = 0; ks < 4; ++ks) { bf16x8 bfr[4];
#pragma unroll
                for (int pt = 0; pt < 4; ++pt) bfr[pt] = frag_gl(pvb, 128, 16 * pt, 32 * ks, c.lane);
#pragma unroll
                for (int tl = 0; tl < 4; ++tl) { const bf16x8 a = frag_rm(Ct, SS_TP, 64 * hb + 16 * tl, 32 * ks, c.lane);
#pragma unroll
                    for (int pt = 0; pt < 4; ++pt) acc[tl][pt] = MFMA16(a, bfr[pt], acc[tl][pt]); } }
#pragma unroll
            for (int tl = 0; tl < 4; ++tl)
#pragma unroll
                for (int i = 0; i < 4; ++i) { const float e = __expf(AC[64 * hb + 16 * tl + 4 * gq + i]);
#pragma unroll
                    for (int pt = 0; pt < 4; ++pt) acc[tl][pt][i] *= e; }
        }
#pragma unroll
        for (int ks = 0; ks < 4; ++ks) if (ks < 2 * hb + 2) {
            stage_qtile(xt, XC + (size_t)(t0 + 32 * ks) * S_CONVD + h * 64, S_CONVD, c.lane);
            bf16x8 bfr[4];
#pragma unroll
            for (int pt = 0; pt < 4; ++pt) bfr[pt] = frag_tr(xt, QT_PITCH, 0, 16 * pt, c.lane);
            float acs[8], dts[8];
#pragma unroll
            for (int j = 0; j < 8; ++j) { acs[j] = AC[32 * ks + 8 * gq + j]; dts[j] = DTL[32 * ks + 8 * gq + j]; }
#pragma unroll
            for (int tl = 0; tl < 4; ++tl) if (4 * hb + tl >= 2 * ks) {
                const int trow = 64 * hb + 16 * tl + r; const float act = AC[trow];
                const v4u cw = *(const LAS v4u*)(Bt + trow * SS_TP + (32 * ks + 8 * gq) * 2);
                const float cbv[8] = {bf_lo(cw.x), bf_hi(cw.x), bf_lo(cw.y), bf_hi(cw.y), bf_lo(cw.z), bf_hi(cw.z), bf_lo(cw.w), bf_hi(cw.w)};
                float v[8];
#pragma unroll
                for (int j = 0; j < 8; ++j) { const int sj = 32 * ks + 8 * gq + j; float x = cbv[j] * __expf(act - acs[j]) * dts[j]; x = (sj <= trow) ? x : 0.f; v[j] = (sj == trow) ? x + Dh : x; }
                v4u aw; aw.x = pk2(v[0], v[1]); aw.y = pk2(v[2], v[3]); aw.z = pk2(v[4], v[5]); aw.w = pk2(v[6], v[7]);
                const bf16x8 a = __builtin_bit_cast(bf16x8, aw);
#pragma unroll
                for (int pt = 0; pt < 4; ++pt) acc[tl][pt] = MFMA16(a, bfr[pt], acc[tl][pt]);
            }
        }
#pragma unroll
        for (int tl = 0; tl < 4; ++tl)
#pragma unroll
            for (int i = 0; i < 4; ++i) { const int tr = 64 * hb + 16 * tl + 4 * gq + i; float ssq = 0.f;
#pragma unroll
                for (int pt = 0; pt < 4; ++pt) { const float z = bf2f(ZX[(size_t)(t0 + tr) * S_ZX + h * 64 + 16 * pt + r]); const float v = acc[tl][pt][i] * silu(z); acc[tl][pt][i] = v; ssq += v * v; }
                ssq += __shfl_xor(ssq, 1); ssq += __shfl_xor(ssq, 2); ssq += __shfl_xor(ssq, 4); ssq += __shfl_xor(ssq, 8);
                if (r == 0) RSS[c.wave * 128 + tr] = ssq; }
        __syncthreads();
#pragma unroll
        for (int tl = 0; tl < 4; ++tl)
#pragma unroll
            for (int i = 0; i < 4; ++i) { const int tr = 64 * hb + 16 * tl + 4 * gq + i; float tot = 0.f;
#pragma unroll
                for (int w = 0; w < 8; ++w) tot += RSS[w * 128 + tr];
                const float rs = rsqrtf(tot * (1.f / 512.f) + EPS);
#pragma unroll
                for (int pt = 0; pt < 4; ++pt) { const int col = h * 64 + 16 * pt + r; MIX[(size_t)(t0 + tr) * S_DI + col] = (bf16)f2bf(acc[tl][pt][i] * rs * nw[col]); } }
        }
        __syncthreads();
    }
}
__device__ __forceinline__ void gla_bcum(const Ctx& c, const float* GL, const float* w2, const float* bg, float* BC) {
    for (int idx = c.gtid; idx < (SEQ / 64) * G_DK; idx += c.NT) {
        const int cc = idx >> 10, col = idx & 1023; float w[16];
#pragma unroll
        for (int r = 0; r < 16; ++r) w[r] = w2[r * G_DK + col];
        const float b = bg[col]; float acc = 0.f;
        for (int t = 0; t < 64; ++t) { const f32x4* gp = (const f32x4*)(GL + (size_t)(cc * 64 + t) * 16); const f32x4 g0 = gp[0], g1 = gp[1], g2 = gp[2], g3 = gp[3];
            float x = b;
            x += g0.x * w[0] + g0.y * w[1] + g0.z * w[2] + g0.w * w[3]; x += g1.x * w[4] + g1.y * w[5] + g1.z * w[6] + g1.w * w[7];
            x += g2.x * w[8] + g2.y * w[9] + g2.z * w[10] + g2.w * w[11]; x += g3.x * w[12] + g3.y * w[13] + g3.z * w[14] + g3.w * w[15];
            acc += -softplus(-x) * (1.f / 16.f);
            BC[(size_t)(cc * 64 + t) * G_DK + col] = acc; }
    }
}
constexpr int GK_P = 528, GK_TILE = 64 * GK_P;
constexpr int GV_P = 144, GV_TILE = 64 * GV_P;
__device__ __forceinline__ v4u scale8(const v4u x, const f32x4 e0, const f32x4 e1) {
    v4u o; o.x = pk2(bf_lo(x.x) * e0.x, bf_hi(x.x) * e0.y); o.y = pk2(bf_lo(x.y) * e0.z, bf_hi(x.y) * e0.w); o.z = pk2(bf_lo(x.z) * e1.x, bf_hi(x.z) * e1.y); o.w = pk2(bf_lo(x.w) * e1.z, bf_hi(x.w) * e1.w); return o;
}
__device__ __forceinline__ f32x4 exp4(const f32x4 a) { return (f32x4){__expf(a.x), __expf(a.y), __expf(a.z), __expf(a.w)}; }
__device__ __forceinline__ void gla_states(const Ctx& c_, LAS unsigned char* lds, const bf16* QKVR, const float* BC, float* KV) {
    LAS unsigned char* Kt = lds; LAS unsigned char* vt = lds + GK_TILE + c_.wave * GV_TILE;
    for (int unit = c_.vcu; unit < (SEQ / 64) * G_H; unit += c_.G) {
        Ctx c = c_; c.lane = opaque_v(c_.lane); c.tid = opaque_v(c_.tid);
        const int h = unit & 3, cc = unit >> 2, t0 = cc * 64;
        for (int it = c.tid; it < 64 * 32; it += NWAVES * 64) { const int s = it >> 5, ch = it & 31;
            const v4u x = *(const v4u*)(QKVR + (size_t)(t0 + s) * G_QKVR + G_DK + h * G_HK + 8 * ch);
            const float* bs = BC + (size_t)(t0 + s) * G_DK + h * G_HK + 8 * ch; const float* be = BC + (size_t)(t0 + 63) * G_DK + h * G_HK + 8 * ch;
            const f32x4 e0 = exp4(*(const f32x4*)be - *(const f32x4*)bs), e1 = exp4(*(const f32x4*)(be + 4) - *(const f32x4*)(bs + 4));
            *(LAS v4u*)(Kt + s * GK_P + ch * 16) = scale8(x, e0, e1); }
        { const bf16* vsrc = QKVR + (size_t)t0 * G_QKVR + 2 * G_DK + h * G_HV + c.wave * 64;
          stage_qtile(vt, vsrc, G_QKVR, c.lane); stage_qtile(vt + 32 * GV_P, vsrc + (size_t)32 * G_QKVR, G_QKVR, c.lane); }
        __syncthreads();
#pragma unroll 1
        for (int kh = 0; kh < 2; ++kh) {
            const int lane = opaque_v(c.lane), gq = lane >> 4, r = lane & 15;
            f32x4 acc[4][8];
#pragma unroll
            for (int a = 0; a < 4; ++a)
#pragma unroll
                for (int b = 0; b < 8; ++b) acc[a][b] = (f32x4){0.f, 0.f, 0.f, 0.f};
#pragma unroll
            for (int ks = 0; ks < 2; ++ks) { bf16x8 afr[4];
#pragma unroll
                for (int v4 = 0; v4 < 4; ++v4) afr[v4] = frag_tr(vt, GV_P, 32 * ks, 16 * v4, lane);
#pragma unroll
                for (int kt = 0; kt < 8; ++kt) { const bf16x8 b = frag_tr(Kt, GK_P, 32 * ks, 128 * kh + 16 * kt, lane);
#pragma unroll
                    for (int v4 = 0; v4 < 4; ++v4) acc[v4][kt] = MFMA16(afr[v4], b, acc[v4][kt]); } }
            float* kvb = KV + ((size_t)(cc * 4 + h) * G_HV + c.wave * 64) * G_HK + 128 * kh;
#pragma unroll
            for (int v4 = 0; v4 < 4; ++v4)
#pragma unroll
                for (int i = 0; i < 4; ++i)
#pragma unroll
                    for (int kt = 0; kt < 8; ++kt) kvb[(size_t)(16 * v4 + 4 * gq + i) * G_HK + 16 * kt + r] = acc[v4][kt][i];
        }
        __syncthreads();
    }
}
__device__ __forceinline__ void gla_chunk_scan(const Ctx& c, const float* KV, const float* BC, bf16* SP) {
    constexpr int NV = G_H * G_HV * G_HK / 4, CS = G_H * G_HV * G_HK;
    for (int idx = c.gtid; idx < NV; idx += c.NT) {
        const int h = idx >> 15, k = (idx & 63) * 4; f32x4 st = (f32x4){0.f, 0.f, 0.f, 0.f};
        for (int c0 = 0; c0 < SEQ / 64; c0 += 8) {
            f32x4 s[8], d[8];
#pragma unroll
            for (int j = 0; j < 8; ++j) { s[j] = *(const f32x4*)(KV + (size_t)(c0 + j) * CS + (size_t)idx * 4); d[j] = *(const f32x4*)(BC + (size_t)((c0 + j) * 64 + 63) * G_DK + h * G_HK + k); }
#pragma unroll
            for (int j = 0; j < 8; ++j) { v2u o; o.x = pk2(st.x, st.y); o.y = pk2(st.z, st.w); *(v2u*)(SP + (size_t)(c0 + j) * CS + (size_t)idx * 4) = o; st = st * exp4(d[j]) + s[j]; }
        }
    }
}
__device__ __forceinline__ void gla_out(const Ctx& c_, LAS unsigned char* lds, const bf16* QKVR, const float* BC, const bf16* SP, const float* nw, bf16* MIX) {
    LAS unsigned char* Qt = lds; LAS unsigned char* Kt = lds + GK_TILE; LAS unsigned char* At = lds + 2 * GK_TILE; LAS unsigned char* vt = lds + 2 * GK_TILE + GV_TILE + c_.wave * GV_TILE;
    LAS float* RSS = (LAS float*)(lds + 2 * GK_TILE + 9 * GV_TILE);
    for (int unit = c_.vcu; unit < (SEQ / 64) * G_H; unit += c_.G) {
        Ctx c = c_; c.lane = opaque_v(c_.lane); c.tid = opaque_v(c_.tid);
        const int gq = c.lane >> 4, r = c.lane & 15;
        const int h = unit & 3, cc = unit >> 2, t0 = cc * 64;
        for (int it = c.tid; it < 64 * 32; it += NWAVES * 64) { const int s = it >> 5, ch = it & 31;
            const bf16* qp = QKVR + (size_t)(t0 + s) * G_QKVR + h * G_HK + 8 * ch;
            const v4u xq = *(const v4u*)qp, xk = *(const v4u*)(qp + G_DK);
            const float* bs = BC + (size_t)(t0 + s) * G_DK + h * G_HK + 8 * ch;
            const f32x4 b0 = *(const f32x4*)bs, b1 = *(const f32x4*)(bs + 4);
            *(LAS v4u*)(Qt + s * GK_P + ch * 16) = scale8(xq, exp4(b0) * (1.f / 16.f), exp4(b1) * (1.f / 16.f));
            *(LAS v4u*)(Kt + s * GK_P + ch * 16) = scale8(xk, exp4(-b0), exp4(-b1)); }
        { const bf16* vsrc = QKVR + (size_t)t0 * G_QKVR + 2 * G_DK + h * G_HV + c.wave * 64;
          stage_qtile(vt, vsrc, G_QKVR, c.lane); stage_qtile(vt + 32 * GV_P, vsrc + (size_t)32 * G_QKVR, G_QKVR, c.lane); }
        __syncthreads();
#pragma unroll 1
        for (int rep = 0; rep < 2; ++rep) {
            const int lane = opaque_v(c.lane), gq2 = lane >> 4, r2 = lane & 15;
            const int id = c.wave + 8 * rep, tt = id >> 2, st = id & 3;
            f32x4 a4 = (f32x4){0.f, 0.f, 0.f, 0.f};
            if (st <= tt) {
#pragma unroll
                for (int ks = 0; ks < 8; ++ks) a4 = MFMA16(frag_rm(Qt, GK_P, 16 * tt, 32 * ks, lane), frag_rm(Kt, GK_P, 16 * st, 32 * ks, lane), a4);
            }
#pragma unroll
            for (int i = 0; i < 4; ++i) { const int tr = 16 * tt + 4 * gq2 + i, sc = 16 * st + r2; *(LAS bf16*)(At + tr * GV_P + sc * 2) = (bf16)f2bf(sc <= tr ? a4[i] : 0.f); }
        }
        __syncthreads();
        f32x4 acc[4][4];
#pragma unroll
        for (int a = 0; a < 4; ++a)
#pragma unroll
            for (int b = 0; b < 4; ++b) acc[a][b] = (f32x4){0.f, 0.f, 0.f, 0.f};
#pragma unroll
        for (int ks = 0; ks < 2; ++ks) { bf16x8 bfr[4];
#pragma unroll
            for (int v4 = 0; v4 < 4; ++v4) bfr[v4] = frag_tr(vt, GV_P, 32 * ks, 16 * v4, c.lane);
#pragma unroll
            for (int tt = 2 * ks; tt < 4; ++tt) { const bf16x8 a = frag_rm(At, GV_P, 16 * tt, 32 * ks, c.lane);
#pragma unroll
                for (int v4 = 0; v4 < 4; ++v4) acc[tt][v4] = MFMA16(a, bfr[v4], acc[tt][v4]); } }
        { const bf16* spb = SP + ((size_t)(cc * 4 + h) * G_HV + c.wave * 64) * G_HK;
#pragma unroll
          for (int ks = 0; ks < 8; ++ks) { bf16x8 bfr[4];
#pragma unroll
            for (int v4 = 0; v4 < 4; ++v4) bfr[v4] = frag_gl(spb, G_HK, 16 * v4, 32 * ks, c.lane);
#pragma unroll
            for (int tt = 0; tt < 4; ++tt) { const bf16x8 a = frag_rm(Qt, GK_P, 16 * tt, 32 * ks, c.lane);
#pragma unroll
                for (int v4 = 0; v4 < 4; ++v4) acc[tt][v4] = MFMA16(a, bfr[v4], acc[tt][v4]); } } }
#pragma unroll
        for (int tt = 0; tt < 4; ++tt)
#pragma unroll
            for (int i = 0; i < 4; ++i) { float ssq = 0.f;
#pragma unroll
                for (int v4 = 0; v4 < 4; ++v4) ssq += acc[tt][v4][i] * acc[tt][v4][i];
                ssq += __shfl_xor(ssq, 1); ssq += __shfl_xor(ssq, 2); ssq += __shfl_xor(ssq, 4); ssq += __shfl_xor(ssq, 8);
                if (r == 0) RSS[c.wave * 64 + 16 * tt + 4 * gq + i] = ssq; }
        __syncthreads();
#pragma unroll
        for (int tt = 0; tt < 4; ++tt)
#pragma unroll
            for (int i = 0; i < 4; ++i) { const int tr = 16 * tt + 4 * gq + i; float tot = 0.f;
#pragma unroll
                for (int w = 0; w < 8; ++w) tot += RSS[w * 64 + tr];
                const float rs = rsqrtf(tot * (1.f / 512.f) + EPS);
#pragma unroll
                for (int v4 = 0; v4 < 4; ++v4) { const int vc = c.wave * 64 + 16 * v4 + r;
                    const float rg = bf2f(QKVR[(size_t)(t0 + tr) * G_QKVR + 2 * G_DK + G_DV + h * G_HV + vc]);
                    MIX[(size_t)(t0 + tr) * G_DV + h * G_HV + vc] = (bf16)f2bf(acc[tt][v4][i] * rs * nw[vc] * silu(rg)); } }
        __syncthreads();
    }
}
constexpr int NPH = 86, PH_FINAL = 85;
enum { KIND_SSD = 0, KIND_GLA = 1, KIND_SGU = 2, KIND_FFN = 3 };
__host__ __device__ inline int step_kind(int s) { return (s % 3 == 1) ? ((s / 3) % 3) : KIND_FFN; }
__host__ __device__ inline bool slot_used(int k) {
    if (k == 0 || k == PH_FINAL) return true;
    const int s = (k - 1) / 7, j = (k - 1) % 7, kind = step_kind(s);
    if (kind == KIND_FFN) return j <= 1 || j == 6;
    if (kind == KIND_SGU) return j <= 3 || j == 6;
    return true;
}
__device__ __forceinline__ int opaque_idx(int i) { asm volatile("" : "+s"(i)); return i; }
struct Args { const float* in[25]; float* out; unsigned char* ws; int ph_lo, ph_hi; };

__global__ void __launch_bounds__(NWAVES * 64, 2) mk_fwd(Args args) {
    extern __shared__ __attribute__((aligned(16))) unsigned char lds_raw[];
    LAS unsigned char* lds = (LAS unsigned char*)lds_raw;
    volatile LAS unsigned* MISC = (volatile LAS unsigned*)(lds + MISC_OFF);
    Ctx c0; c0.tid = threadIdx.x; c0.lane = c0.tid & 63; c0.wave = __builtin_amdgcn_readfirstlane(c0.tid >> 6);
    c0.G = gridDim.x; { const int bx = blockIdx.x; c0.vcu = (c0.G % 8 == 0) ? (bx % 8) * (c0.G / 8) + bx / 8 : bx; }
    c0.gw = c0.vcu * NWAVES + c0.wave; c0.NGW = c0.G * NWAVES; c0.gtid = c0.vcu * (NWAVES * 64) + c0.tid; c0.NT = c0.G * NWAVES * 64;
    unsigned char* ws = args.ws;
    unsigned* ctl = (unsigned*)(ws + WS_CTL);
    for (int u = c0.tid; u < (LDS_BYTES - LDSCTL_OFF) / 4; u += NWAVES * 64) ((LAS unsigned*)(lds + LDSCTL_OFF))[u] = 0u;
    __syncthreads();
    const int lo = args.ph_lo, hi = args.ph_hi;
    const bool fused = (hi - lo) > 1;
    XcdBarrier bar; bar.bar = ctl + CW_BAR; bar.x = 0; bar.st = nullptr;
    if (fused) bar = xcd_barrier_post(ctl + CW_BAR, MISC + 8);
#define IN(k) (lo <= (k) && (k) < hi)
#define SEAM() do { if (fused) xcd_barrier(bar); } while (0)
#define FRESH() Ctx c = c0; asm volatile("" : "+v"(c.tid), "+v"(c.lane), "+v"(c.gtid)); asm volatile("" : "+s"(c.gw), "+s"(c.NGW), "+s"(c.NT))
#define INP(i) (args.in[opaque_idx(i)])

    float* H = (float*)(ws + WS_H); bf16* HN = (bf16*)(ws + WS_HN); bf16* BIG = (bf16*)(ws + WS_BIG); bf16* MIX = (bf16*)(ws + WS_MIX);
    unsigned char* scr = ws + WS_SCR;

    if (IN(0)) {
        FRESH();
        LAS float* tscr = (LAS float*)(lds + RING_OFF + c.wave * 16384);
        for (int i = 0; i < 8; ++i) {
            convert_matrix<1>(c, tscr, INP(2) + (size_t)i * DM * 2 * DFF, DM, 2 * DFF, 2 * DFF, (bf16*)(ws + WS_W_FFN_IN + i * SZ_FFN_IN));
            convert_matrix<0>(c, tscr, INP(3) + (size_t)i * DFF * DM, DFF, DM, DM, (bf16*)(ws + WS_W_FFN_OUT + i * SZ_FFN_OUT));
        }
        for (int i = 0; i < 2; ++i) {
            convert_matrix<0>(c, tscr, INP(5) + (size_t)i * DM * S_IN, DM, S_IN, S_INP, (bf16*)(ws + WS_W_SSD_IN + i * SZ_SSD_IN));
            convert_matrix<0>(c, tscr, INP(12) + (size_t)i * S_DI * DM, S_DI, DM, DM, (bf16*)(ws + WS_W_SSD_OUT + i * SZ_SSD_OUT));
        }
        convert_matrix<0>(c, tscr, INP(13), DM, G_IN, G_INP, (bf16*)(ws + WS_W_GLA_IN));
        convert_matrix<0>(c, tscr, INP(17), G_DV, DM, DM, (bf16*)(ws + WS_W_GLA_OUT));
        convert_matrix<0>(c, tscr, INP(18), DM, 2 * U_W, 2 * U_W, (bf16*)(ws + WS_W_SGU_IN));
        convert_matrix<0>(c, tscr, INP(23), U_W, DM, DM, (bf16*)(ws + WS_W_SGU_OUT));
        { const f32x4* src = (const f32x4*)INP(0); f32x4* dst = (f32x4*)H;
          for (int i = c.gtid; i < SEQ * DM / 4; i += c.NT) dst[i] = src[i]; }
        SEAM();
    }

    for (int s = 0; s < 3 * DEPTH; ++s) {
        const int base = 1 + 7 * s, layer = s / 3, sub = s % 3, kind = step_kind(s), mj = layer / 3, fi = layer * 2 + (sub >> 1);
        if (IN(base)) {
            FRESH();
            const float* gain = (sub == 1) ? INP(4) + (size_t)layer * DM : INP(1) + (size_t)fi * DM;
            rmsnorm_rows<true>(c, H, gain, HN);
            SEAM();
        }
        if (IN(base + 1)) {
            if (kind == KIND_FFN) {
                pg8::Gemm g{HN, (const bf16*)(ws + WS_W_FFN_IN + fi * SZ_FFN_IN), SEQ, 2 * DFF, DM}; pg8::StaticOrder S; S.init(SEQ, 2 * DFF, c0.G, (int)blockIdx.x);
                pg8::EpiSwiGLU E{BIG, DFF};
                pg8::gemm_phase<pg8::EpiSwiGLU, pg8::StaticOrder, true, true>(lds + RING_OFF, g, S, E);
            } else {
                const bf16* W = (const bf16*)(ws + (kind == KIND_SSD ? WS_W_SSD_IN + mj * SZ_SSD_IN : kind == KIND_GLA ? WS_W_GLA_IN : WS_W_SGU_IN));
                const int Np = kind == KIND_SSD ? S_INP : kind == KIND_GLA ? G_INP : 2 * U_W, ldo = kind == KIND_SSD ? S_ZX : kind == KIND_GLA ? G_QKVR : 2 * U_W;
                pg8::Gemm g{HN, W, SEQ, Np, DM}; pg8::StaticOrder S; S.init(SEQ, Np, c0.G, (int)blockIdx.x);
                pg8::EpiBf16X E{BIG, ldo, kind == KIND_SGU ? INP(19) : nullptr, ldo / 256, (float*)(scr + (kind == KIND_SSD ? SC_DTR : SC_GL)), kind == KIND_SSD ? 64 : 16};
                pg8::gemm_phase<pg8::EpiBf16X, pg8::StaticOrder, true, true>(lds + RING_OFF, g, S, E);
            }
            SEAM();
        }
        if (kind == KIND_SSD) {
            bf16* XC = (bf16*)(scr + SC_XC); float* DTR = (float*)(scr + SC_DTR); float* DT = (float*)(scr + SC_DT); float* ST = (float*)(scr + SC_ST); bf16* PV = (bf16*)(scr + SC_PV); float* CD = (float*)(scr + SC_CD);
            if (IN(base + 2)) { FRESH(); ssd_conv_dt(c, BIG, INP(6) + (size_t)mj * S_CONVD * 4, INP(7) + (size_t)mj * S_CONVD, DTR, INP(8) + mj * 64, XC, DT); SEAM(); }
            if (IN(base + 3)) { FRESH(); ssd_states(c, lds, XC, DT, INP(9) + mj * 64, ST, CD); SEAM(); }
            if (IN(base + 4)) { FRESH(); ssd_chunk_scan(c, ST, CD, PV); SEAM(); }
            if (IN(base + 5)) { FRESH(); ssd_out(c, lds, XC, BIG, DT, INP(9) + mj * 64, INP(10) + mj * 64, PV, INP(11) + (size_t)mj * S_DI, MIX); SEAM(); }
        } else if (kind == KIND_GLA) {
            float* GL = (float*)(scr + SC_GL); float* BC = (float*)(scr + SC_BC); float* KV = (float*)(scr + SC_KV); bf16* SP = (bf16*)(scr + SC_SP);
            if (IN(base + 2)) { FRESH(); gla_bcum(c, GL, INP(14), INP(15), BC); SEAM(); }
            if (IN(base + 3)) { FRESH(); gla_states(c, lds, BIG, BC, KV); SEAM(); }
            if (IN(base + 4)) { FRESH(); gla_chunk_scan(c, KV, BC, SP); SEAM(); }
            if (IN(base + 5)) { FRESH(); gla_out(c, lds, BIG, BC, SP, INP(16), MIX); SEAM(); }
        } else if (kind == KIND_SGU) {
            float* RS = (float*)(scr + SC_RS);
            if (IN(base + 2)) { FRESH(); sgu_rstd(c, BIG, RS); SEAM(); }
            if (IN(base + 3)) { FRESH(); sgu_mix(c, lds, BIG, RS, INP(21), INP(22), INP(20), MIX); SEAM(); }
        }
        if (IN(base + 6)) {
            const bf16* A = kind == KIND_FFN ? BIG : MIX;
            const bf16* W = (const bf16*)(ws + (kind == KIND_FFN ? WS_W_FFN_OUT + fi * SZ_FFN_OUT : kind == KIND_SSD ? WS_W_SSD_OUT + mj * SZ_SSD_OUT : kind == KIND_GLA ? WS_W_GLA_OUT : WS_W_SGU_OUT));
            const int K = kind == KIND_FFN ? DFF : kind == KIND_GLA ? G_DV : 4096;
            pg8::Gemm g{A, W, SEQ, DM, K}; pg8::StaticOrder S; S.init(SEQ, DM, c0.G, (int)blockIdx.x);
            pg8::EpiResid E{H, DM, kind == KIND_FFN ? 0.5f : 1.0f};
            pg8::gemm_phase<pg8::EpiResid, pg8::StaticOrder, true, true>(lds + RING_OFF, g, S, E);
            SEAM();
        }
    }
    if (IN(PH_FINAL)) { FRESH(); rmsnorm_rows<false>(c, H, INP(24), args.out); }
#undef IN
#undef SEAM
#undef FRESH
#undef INP
}

extern "C" void kernel_launch(void* const* d_in, const int* in_sizes, int n_in, void* d_out, int out_size, void* d_ws, size_t ws_size, hipStream_t stream) {
    static int grid = 0;
    if (grid == 0) {
        if (n_in != 25 || out_size != SEQ * DM || ws_size < WS_END) { fprintf(stderr, "kernel_launch: unexpected problem (n_in %d, out %d, ws %zu < %zu)\n", n_in, out_size, ws_size, (size_t)WS_END); grid = -1; return; }
        int dev = 0, cus = 0, per_cu = 0;
        if (hipGetDevice(&dev) != hipSuccess || hipDeviceGetAttribute(&cus, hipDeviceAttributeMultiprocessorCount, dev) != hipSuccess) { grid = -1; return; }
        if (hipFuncSetAttribute((const void*)mk_fwd, hipFuncAttributeMaxDynamicSharedMemorySize, LDS_BYTES) != hipSuccess) { fprintf(stderr, "kernel_launch: hipFuncSetAttribute failed\n"); grid = -1; return; }
        if (hipOccupancyMaxActiveBlocksPerMultiprocessor(&per_cu, (const void*)mk_fwd, NWAVES * 64, LDS_BYTES) != hipSuccess || per_cu < 1) fprintf(stderr, "kernel_launch: occupancy query reports %d\n", per_cu);
        (void)hipGetLastError();
        grid = cus;
    }
    if (grid < 0) return;
    if (hipMemsetAsync((char*)d_ws + WS_CTL, 0, CTL_ZERO_BYTES, stream) != hipSuccess) return;
    Args a{};
    for (int i = 0; i < 25; ++i) a.in[i] = (const float*)d_in[i];
    a.out = (float*)d_out; a.ws = (unsigned char*)d_ws;
#if MK_PER_PHASE
    for (int k = 0; k < NPH; ++k) { if (!slot_used(k)) continue; a.ph_lo = k; a.ph_hi = k + 1;
        hipLaunchKernelGGL(mk_fwd, dim3(grid), dim3(NWAVES * 64), LDS_BYTES, stream, a); }
#else
    a.ph_lo = 0; a.ph_hi = NPH;
    hipLaunchKernelGGL(mk_fwd, dim3(grid), dim3(NWAVES * 64), LDS_BYTES, stream, a);
#endif
    const hipError_t le = hipPeekAtLastError();
    if (le != hipSuccess) fprintf(stderr, "kernel_launch: launch failed: %s\n", hipGetErrorName(le));
}
```

```cpp
#include <hip/hip_runtime.h>
#include <cstdio>
#include <cstdint>
#ifndef MK_PER_PHASE
#define MK_PER_PHASE 0
#endif
#ifndef PROBE_DUP
#define PROBE_DUP 0
#endif
#undef MK_PER_PHASE
#define MK_PER_PHASE 0
namespace pg8 {
#define PG8_LAS __attribute__((address_space(3)))
typedef unsigned short bf16_t;
typedef short bf16x8 __attribute__((ext_vector_type(8)));
typedef float f32x4 __attribute__((ext_vector_type(4)));
typedef unsigned u32x4 __attribute__((ext_vector_type(4)));
constexpr int BM = 256, BK = 64, HALF = 128, HTB = HALF * BK * 2  , STAGE_BYTES = 8 * HTB, NXCD = 8, WGM = 8;

__host__ __device__ __forceinline__ int lds_byte(int r, int c) { const int st = (r >> 4) * 2 + (c >> 5), rr = r & 15, cc = c & 31, ob = rr * 64 + cc * 2; return st * 1024 + (ob ^ (((ob >> 9) & 1) << 5)); }
__host__ __device__ __forceinline__ void stage_rc(int b, int& R, int& C) { const int st = b / 1024, sb = b % 1024, swz = sb ^ (((sb >> 9) & 1) << 5); R = (st >> 1) * 16 + swz / 64; C = (st & 1) * 32 + (swz % 64) / 2; }
__host__ __device__ __forceinline__ int perm32(int rho) { const int n = rho >> 4, i = rho & 15; return 8 * (i >> 2) + 4 * n + (i & 3); }

struct Unit { int pm, pn; };
struct Gemm { const bf16_t* A; const bf16_t* Bt; int M, N, K; };

struct StaticOrder {
    int nM, nN, nwg, G, c;
    __host__ __device__ void init(int M, int N, int G_, int c_) { nM = M / BM; nN = N / BM; nwg = nM * nN; G = G_; c = c_; }
    __host__ __device__ bool next(int i, Unit& u) const {
        const long L = (long)i * G + c; if (L >= nwg) return false;
        int wgid = (int)L; { const int q = nwg / NXCD, r = nwg % NXCD, xcd = wgid % NXCD, off = wgid / NXCD; wgid = (xcd < r ? xcd * (q + 1) : r * (q + 1) + (xcd - r) * q) + off; }
        const int nig = WGM * nN, gid = wgid / nig, fm = gid * WGM, gsz = (nM - fm) < WGM ? (nM - fm) : WGM;
        u.pm = fm + ((wgid % nig) % gsz); u.pn = (wgid % nig) / gsz; return true;
    }
    __device__ __forceinline__ void a_ready(const Unit&) const {}
    __device__ __forceinline__ void done(const Unit&) const {}
};
__device__ __forceinline__ unsigned cvt_pk_bf16(float lo, float hi) { unsigned r; asm volatile("v_cvt_pk_bf16_f32 %0, %1, %2" : "=v"(r) : "v"(lo), "v"(hi)); return r; }
typedef float f32x2 __attribute__((ext_vector_type(2)));
__device__ __forceinline__ f32x2 gelu_pk(f32x2 v) {
    const f32x2 av = __builtin_elementwise_abs(v), d = av * 0.2316418882f + 1.0f;
    f32x2 t; t.x = __builtin_amdgcn_rcpf(d.x); t.y = __builtin_amdgcn_rcpf(d.y);
    f32x2 q = t * 0.5307027145f + (-0.7265760135f); q = q * t + 0.7107068705f; q = q * t + (-0.142248368f); q = q * t + 0.127414796f; q = q * t;
    const f32x2 s = (v * v) * (-0.72134752044f);
    f32x2 e; e.x = __builtin_amdgcn_exp2f(s.x); e.y = __builtin_amdgcn_exp2f(s.y);
    const f32x2 m = v * (q * e), r = v - m;
    f32x2 o; o.x = v.x < 0.f ? m.x : r.x; o.y = v.y < 0.f ? m.y : r.y; return o;
}
__device__ __forceinline__ float silu_f(float x) { return x / (1.0f + __expf(-x)); }
__device__ __forceinline__ u32x4 pack8(const f32x4 v0, const f32x4 v1) { u32x4 w; w.x = cvt_pk_bf16(v0[0], v0[1]); w.y = cvt_pk_bf16(v0[2], v0[3]); w.z = cvt_pk_bf16(v1[0], v1[1]); w.w = cvt_pk_bf16(v1[2], v1[3]); return w; }

struct EpiSwiGLU {
    static constexpr bool PERM = true, AFTER_DRAIN = false;
    bf16_t* O; int ldc;
    __device__ __forceinline__ void operator()(const f32x4 (&acc)[2][2][4][2], const Unit& u, int wr, int wc, int fr, int fq) const {
        const int row0 = u.pm * BM + wr * 64 + fr, col0 = u.pn * HALF + wc * 32 + 8 * fq;
#pragma unroll
        for (int ai = 0; ai < 2; ++ai)
#pragma unroll
            for (int m = 0; m < 4; ++m) { bf16_t* rowp = O + (size_t)(row0 + ai * HALF + m * 16) * ldc + col0;
                f32x4 o0, o1;
#pragma unroll
                for (int i = 0; i < 4; ++i) { o0[i] = silu_f(acc[ai][0][m][0][i]) * acc[ai][1][m][0][i]; o1[i] = silu_f(acc[ai][0][m][1][i]) * acc[ai][1][m][1][i]; }
                *(u32x4*)rowp = pack8(o0, o1); }
    }
};
struct EpiResid {
    static constexpr bool PERM = false, AFTER_DRAIN = false;
    float* H; int ldc; float scale;
    __device__ __forceinline__ void operator()(const f32x4 (&acc)[2][2][4][2], const Unit& u, int wr, int wc, int fr, int fq) const {
        const int row0 = u.pm * BM + wr * 64 + fr, col0 = u.pn * BM + wc * 32 + 4 * fq;
#pragma unroll
        for (int ai = 0; ai < 2; ++ai)
#pragma unroll
            for (int m = 0; m < 4; ++m) { float* rowp = H + (size_t)(row0 + ai * HALF + m * 16) * ldc + col0;
#pragma unroll
                for (int bj = 0; bj < 2; ++bj)
#pragma unroll
                    for (int n = 0; n < 2; ++n) { f32x4* p = (f32x4*)(rowp + bj * HALF + n * 16); *p = *p + acc[ai][bj][m][n] * scale; } }
    }
};
struct EpiBf16X {
    static constexpr bool PERM = true, AFTER_DRAIN = false;
    bf16_t* O; int ldc; const float* bias; int npn_main; float* X; int nx;
    __device__ __forceinline__ void operator()(const f32x4 (&acc)[2][2][4][2], const Unit& u, int wr, int wc, int fr, int fq) const {
        const int row0 = u.pm * BM + wr * 64 + fr;
        if (u.pn < npn_main) {
            const int col0 = u.pn * BM + wc * 32 + 8 * fq;
            f32x4 bv[2][2];
#pragma unroll
            for (int bj = 0; bj < 2; ++bj)
#pragma unroll
                for (int n = 0; n < 2; ++n) bv[bj][n] = bias ? *(const f32x4*)(bias + col0 + bj * HALF + 4 * n) : (f32x4){0.f, 0.f, 0.f, 0.f};
#pragma unroll
            for (int ai = 0; ai < 2; ++ai)
#pragma unroll
                for (int m = 0; m < 4; ++m) { bf16_t* rowp = O + (size_t)(row0 + ai * HALF + m * 16) * ldc + col0;
#pragma unroll
                    for (int bj = 0; bj < 2; ++bj) { f32x4 v0 = acc[ai][bj][m][0] + bv[bj][0], v1 = acc[ai][bj][m][1] + bv[bj][1];
                        if (bias) { f32x2 a = gelu_pk((f32x2){v0[0], v0[1]}), b = gelu_pk((f32x2){v0[2], v0[3]}), c = gelu_pk((f32x2){v1[0], v1[1]}), d = gelu_pk((f32x2){v1[2], v1[3]});
                            v0 = (f32x4){a.x, a.y, b.x, b.y}; v1 = (f32x4){c.x, c.y, d.x, d.y}; }
                        *(u32x4*)(rowp + bj * HALF) = pack8(v0, v1); } }
        } else {
            const int c0 = wc * 32 + 8 * fq;
            if (c0 < nx) {
#pragma unroll
                for (int ai = 0; ai < 2; ++ai)
#pragma unroll
                    for (int m = 0; m < 4; ++m) { float* rowp = X + (size_t)(row0 + ai * HALF + m * 16) * nx + c0;
                        *(f32x4*)rowp = acc[ai][0][m][0]; *(f32x4*)(rowp + 4) = acc[ai][0][m][1]; }
            }
        }
    }
};
template <class Epi, class Sched, bool ALIGN_EPI = false, bool SP2 = false>
__device__ __forceinline__ void gemm_phase(PG8_LAS unsigned char* lds, const Gemm g, const Sched& S, const Epi& E) {
    int tid_ = threadIdx.x; asm volatile("" : "+v"(tid_));
    const int tid = tid_, wid = __builtin_amdgcn_readfirstlane(tid >> 6), lane = tid & 63, wr = wid >> 2, wc = wid & 3, fr = lane & 15, fq = lane >> 4;
    const int K = g.K, nt = K / BK;
    unsigned voffA[2], voffB[2];
#pragma unroll
    for (int i = 0; i < 2; ++i) { int R, C; stage_rc(tid * 16 + i * 8192, R, C); const int Rb = Epi::PERM ? ((R & ~31) + perm32(R & 31)) : R;
        voffA[i] = (unsigned)(R * K + C) * 2u; voffB[i] = (unsigned)(Rb * K + C) * 2u; }
    const size_t kstep = (size_t)(BK * 2);
    const size_t hstep = (size_t)HALF * K * 2;
    const size_t tstep = 2 * hstep;
    const unsigned ldsw = (unsigned)wid * 1024u;
    const int aoff = lds_byte(wr * 64 + fr, fq * 8), boff = lds_byte(wc * 32 + fr, fq * 8);
#define PG8_SA(b, h) (((b) * 2 + (h)) * HTB)
#define PG8_SB(b, h) ((4 + (b) * 2 + (h)) * HTB)
#define PG8_STAGE(bufoff, gbase, voff) do { _Pragma("unroll") for (int _i = 0; _i < 2; ++_i) \
        __builtin_amdgcn_global_load_lds((const unsigned*)((const char*)(gbase) + (voff)[_i]), (PG8_LAS unsigned*)(lds + (bufoff) + ldsw + _i * 8192), 16, 0, 0); } while (0)
#define PG8_LDA(dst, b, h) do { _Pragma("unroll") for (int m = 0; m < 4; ++m) _Pragma("unroll") for (int k = 0; k < 2; ++k) dst[m][k] = *(const PG8_LAS bf16x8*)(lds + PG8_SA(b, h) + aoff + m * 2048 + k * 1024); } while (0)
#define PG8_LDB(dst, b, h) do { _Pragma("unroll") for (int n = 0; n < 2; ++n) _Pragma("unroll") for (int k = 0; k < 2; ++k) dst[n][k] = *(const PG8_LAS bf16x8*)(lds + PG8_SB(b, h) + boff + n * 2048 + k * 1024); } while (0)
#define PG8_MMA(ai, bj, At, Bt) do { __builtin_amdgcn_s_setprio(1); _Pragma("unroll") for (int m = 0; m < 4; ++m) _Pragma("unroll") for (int n = 0; n < 2; ++n) _Pragma("unroll") for (int k = 0; k < 2; ++k) \
        acc[ai][bj][m][n] = __builtin_amdgcn_mfma_f32_16x16x32_bf16(Bt[n][k], At[m][k], acc[ai][bj][m][n], 0, 0, 0); __builtin_amdgcn_s_setprio(0); } while (0)
#define PG8_WAIT_V(n) asm volatile("s_waitcnt vmcnt(" #n ")" ::: "memory")
#define PG8_WAIT_L(n) asm volatile("s_waitcnt lgkmcnt(" #n ")" ::: "memory")
#define PG8_BAR __builtin_amdgcn_s_barrier()
#define PG8_SCHED __builtin_amdgcn_sched_barrier(0)
    Unit cur, nxt; int ui = 0;
    if (!S.next(0, cur)) return;
    f32x4 acc[2][2][4][2];
#pragma unroll
    for (int a = 0; a < 2; ++a)
#pragma unroll
        for (int b = 0; b < 2; ++b)
#pragma unroll
            for (int m = 0; m < 4; ++m)
#pragma unroll
                for (int n = 0; n < 2; ++n) acc[a][b][m][n] = (f32x4){0.f, 0.f, 0.f, 0.f};
    bf16x8 At[4][2], B0[2][2], B1[2][2];
    const char* cA = (const char*)g.A + (size_t)cur.pm * tstep; const char* cB = (const char*)g.Bt + (size_t)cur.pn * tstep;
    S.a_ready(cur);
    if constexpr (SP2) {
        PG8_STAGE(PG8_SB(0, 0), cB, voffB); PG8_STAGE(PG8_SB(0, 1), cB + hstep, voffB); PG8_STAGE(PG8_SA(0, 0), cA, voffA); PG8_STAGE(PG8_SA(0, 1), cA + hstep, voffA);
        if (wr == 1) PG8_BAR;
        PG8_WAIT_V(2); PG8_BAR;
        PG8_STAGE(PG8_SB(1, 0), cB + kstep, voffB); PG8_STAGE(PG8_SA(1, 0), cA + kstep, voffA); PG8_STAGE(PG8_SB(1, 1), cB + hstep + kstep, voffB);
        PG8_WAIT_V(6); PG8_BAR;
    } else {
        PG8_STAGE(PG8_SB(0, 0), cB, voffB); PG8_STAGE(PG8_SA(0, 0), cA, voffA); PG8_STAGE(PG8_SB(0, 1), cB + hstep, voffB); PG8_STAGE(PG8_SA(0, 1), cA + hstep, voffA);
        if (wr == 1) PG8_BAR;
        PG8_WAIT_V(4); PG8_BAR;
        PG8_STAGE(PG8_SB(1, 0), cB + kstep, voffB); PG8_STAGE(PG8_SA(1, 0), cA + kstep, voffA); PG8_STAGE(PG8_SB(1, 1), cB + hstep + kstep, voffB);
        PG8_WAIT_V(6); PG8_BAR;
    }
    for (;;) {
        const bool has_next = S.next(ui + 1, nxt);
        const char* nA = has_next ? (const char*)g.A + (size_t)nxt.pm * tstep : cA; const char* nB = has_next ? (const char*)g.Bt + (size_t)nxt.pn * tstep : cB;
        for (int t = 0; t < nt; t += 2) {
            const bool last = (t == nt - 2);
            const char* a1 = cA + (size_t)(t + 1) * kstep;
            const char* a2 = last ? nA : cA + (size_t)(t + 2) * kstep; const char* b2 = last ? nB : cB + (size_t)(t + 2) * kstep;
            const char* a3 = a2 + kstep; const char* b3 = b2 + kstep;
            if (last && has_next) S.a_ready(nxt);
            if constexpr (SP2) {
            PG8_LDB(B0, 0, 0); PG8_LDB(B1, 0, 1); PG8_SCHED; PG8_LDA(At, 0, 0); PG8_STAGE(PG8_SA(1, 1), a1 + hstep, voffA);
            PG8_WAIT_V(8); PG8_WAIT_L(0); PG8_BAR; PG8_MMA(0, 0, At, B0); PG8_MMA(0, 1, At, B1); PG8_BAR; PG8_SCHED;
            PG8_LDA(At, 0, 1); PG8_STAGE(PG8_SB(0, 0), b2, voffB); PG8_STAGE(PG8_SB(0, 1), b2 + hstep, voffB); PG8_STAGE(PG8_SA(0, 0), a2, voffA);
            PG8_WAIT_V(8); PG8_WAIT_L(0); PG8_BAR; PG8_MMA(1, 0, At, B0); PG8_MMA(1, 1, At, B1); PG8_BAR; PG8_SCHED;
            PG8_LDB(B0, 1, 0); PG8_LDB(B1, 1, 1); PG8_SCHED; PG8_LDA(At, 1, 0); PG8_STAGE(PG8_SA(0, 1), a2 + hstep, voffA);
            PG8_WAIT_V(8); PG8_WAIT_L(0); PG8_BAR; PG8_MMA(0, 0, At, B0); PG8_MMA(0, 1, At, B1); PG8_BAR; PG8_SCHED;
            PG8_LDA(At, 1, 1); PG8_STAGE(PG8_SB(1, 0), b3, voffB); PG8_STAGE(PG8_SB(1, 1), b3 + hstep, voffB); PG8_STAGE(PG8_SA(1, 0), a3, voffA);
            PG8_WAIT_V(8); PG8_WAIT_L(0); PG8_BAR; PG8_MMA(1, 0, At, B0); PG8_MMA(1, 1, At, B1); PG8_BAR; PG8_SCHED;
            } else {
            PG8_LDB(B0, 0, 0); PG8_SCHED; PG8_LDA(At, 0, 0); PG8_STAGE(PG8_SA(1, 1), a1 + hstep, voffA);
            PG8_WAIT_L(8); PG8_BAR; PG8_WAIT_L(0); PG8_MMA(0, 0, At, B0); PG8_BAR; PG8_SCHED;
            PG8_LDB(B1, 0, 1); PG8_STAGE(PG8_SB(0, 0), b2, voffB);
            PG8_BAR; PG8_WAIT_L(0); PG8_MMA(0, 1, At, B1); PG8_BAR;
            PG8_LDA(At, 0, 1); PG8_STAGE(PG8_SA(0, 0), a2, voffA);
            PG8_BAR; PG8_WAIT_L(0); PG8_MMA(1, 0, At, B0); PG8_BAR; PG8_SCHED;
            PG8_STAGE(PG8_SB(0, 1), b2 + hstep, voffB);
            PG8_WAIT_V(6); PG8_BAR; PG8_MMA(1, 1, At, B1); PG8_BAR;
            PG8_LDB(B0, 1, 0); PG8_SCHED; PG8_LDA(At, 1, 0); PG8_STAGE(PG8_SA(0, 1), a2 + hstep, voffA);
            PG8_WAIT_L(8); PG8_BAR; PG8_WAIT_L(0); PG8_MMA(0, 0, At, B0); PG8_BAR; PG8_SCHED;
            PG8_LDB(B1, 1, 1); PG8_STAGE(PG8_SB(1, 0), b3, voffB);
            PG8_BAR; PG8_WAIT_L(0); PG8_MMA(0, 1, At, B1); PG8_BAR;
            PG8_LDA(At, 1, 1); PG8_STAGE(PG8_SA(1, 0), a3, voffA);
            PG8_BAR; PG8_WAIT_L(0); PG8_MMA(1, 0, At, B0); PG8_BAR; PG8_SCHED;
            PG8_STAGE(PG8_SB(1, 1), b3 + hstep, voffB);
            PG8_WAIT_V(6); PG8_BAR; PG8_MMA(1, 1, At, B1); PG8_BAR;
            }
        }
        if constexpr (ALIGN_EPI) { if (wr == 0) PG8_BAR; }
        if constexpr (!Epi::AFTER_DRAIN) { E(acc, cur, wr, wc, fr, fq); S.done(cur); }
        if (!has_next) break;
#pragma unroll
        for (int a = 0; a < 2; ++a)
#pragma unroll
            for (int b = 0; b < 2; ++b)
#pragma unroll
                for (int m = 0; m < 4; ++m)
#pragma unroll
                    for (int n = 0; n < 2; ++n) acc[a][b][m][n] = (f32x4){0.f, 0.f, 0.f, 0.f};
        cur = nxt; cA = nA; cB = nB; ++ui;
        if constexpr (ALIGN_EPI) { if (wr == 1) PG8_BAR; }
    }
    PG8_WAIT_V(0);
    if constexpr (!ALIGN_EPI) { if (wr == 0) PG8_BAR; }
    PG8_BAR;
    if constexpr (Epi::AFTER_DRAIN) { E.fused(acc, cur, wr, wc, fr, fq, lds, wid, lane); S.done(cur); }
#undef PG8_SA
#undef PG8_SB
#undef PG8_STAGE
#undef PG8_LDA
#undef PG8_LDB
#undef PG8_MMA
#undef PG8_WAIT_V
#undef PG8_WAIT_L
#undef PG8_BAR
#undef PG8_SCHED
}
}
constexpr int SEQ = 8192, DM = 2048, DFF = 5632, DEPTH = 4, NWAVES = 8;
constexpr float EPS = 1e-6f;
constexpr int S_DI = 4096, S_NH = 64, S_P = 64, S_G = 8, S_N = 128, S_CONVD = 6144, S_IN = 10304, S_INP = 10496, S_ZX = 10240;
constexpr int G_H = 4, G_DK = 1024, G_DV = 2048, G_HK = 256, G_HV = 512, G_R = 16, G_IN = 6160, G_INP = 6400, G_QKVR = 6144;
constexpr int U_W = 4096, U_G = 8, U_GD = 512, U_Q = 128;

constexpr size_t MiB = 1u << 20;
constexpr size_t WS_CTL = 0, CTL_ZERO_BYTES = 1 * MiB;
constexpr size_t SZ_FFN_IN = (size_t)2 * DFF * DM * 2, SZ_FFN_OUT = (size_t)DM * DFF * 2;
constexpr size_t SZ_SSD_IN = (size_t)S_INP * DM * 2, SZ_SSD_OUT = (size_t)DM * S_DI * 2;
constexpr size_t WS_W_FFN_IN = 1 * MiB;
constexpr size_t WS_W_FFN_OUT = WS_W_FFN_IN + 8 * SZ_FFN_IN;
constexpr size_t WS_W_SSD_IN = WS_W_FFN_OUT + 8 * SZ_FFN_OUT;
constexpr size_t WS_W_SSD_OUT = WS_W_SSD_IN + 2 * SZ_SSD_IN;
constexpr size_t WS_W_GLA_IN = WS_W_SSD_OUT + 2 * SZ_SSD_OUT;
constexpr size_t WS_W_GLA_OUT = WS_W_GLA_IN + (size_t)G_INP * DM * 2;
constexpr size_t WS_W_SGU_IN = WS_W_GLA_OUT + (size_t)DM * G_DV * 2;
constexpr size_t WS_W_SGU_OUT = WS_W_SGU_IN + (size_t)2 * U_W * DM * 2;
constexpr size_t WS_W_END = WS_W_SGU_OUT + (size_t)DM * U_W * 2;
constexpr size_t WS_H = (WS_W_END + MiB - 1) / MiB * MiB;
constexpr size_t WS_HN = WS_H + (size_t)SEQ * DM * 4;
constexpr size_t WS_BIG = WS_HN + (size_t)SEQ * DM * 2;
constexpr size_t WS_MIX = WS_BIG + (size_t)SEQ * S_ZX * 2;
constexpr size_t WS_SCR = WS_MIX + (size_t)SEQ * 4096 * 2;
constexpr size_t WS_SCR_BYTES = 512 * MiB;
constexpr size_t WS_END = WS_SCR + WS_SCR_BYTES;
static_assert(WS_H % 256 == 0 && WS_W_SSD_IN % 256 == 0 && WS_W_GLA_IN % 256 == 0, "alignment");
constexpr size_t SC_XC = 0;
constexpr size_t SC_DTR = SC_XC + (size_t)SEQ * S_CONVD * 2;
constexpr size_t SC_DT = SC_DTR + (size_t)SEQ * 64 * 4;
constexpr size_t SC_ST = SC_DT + (size_t)SEQ * 64 * 4;
constexpr size_t SC_PV = SC_ST + (size_t)64 * 64 * 64 * 128 * 4;
constexpr size_t SC_CD = SC_PV + (size_t)64 * 64 * 64 * 128 * 2;
constexpr size_t SC_SSD_END = SC_CD + 64 * 64 * 4;
constexpr size_t SC_GL = 0;
constexpr size_t SC_BC = SC_GL + (size_t)SEQ * 16 * 4;
constexpr size_t SC_KV = SC_BC + (size_t)SEQ * 1024 * 4;
constexpr size_t SC_SP = SC_KV + (size_t)128 * 4 * 512 * 256 * 4;
constexpr size_t SC_GLA_END = SC_SP + (size_t)128 * 4 * 512 * 256 * 2;
constexpr size_t SC_RS = 0;
static_assert(SC_SSD_END <= WS_SCR_BYTES && SC_GLA_END <= WS_SCR_BYTES, "scratch map");
constexpr int CW_BAR = 4096;

constexpr int RING_OFF = 0, RING_BYTES = 131072;
constexpr int LDS_BYTES = 163840;
constexpr int LDSCTL_OFF = LDS_BYTES - 1024, MISC_OFF = LDSCTL_OFF + 320;

#define GAS __attribute__((address_space(1)))
#define LAS __attribute__((address_space(3)))
typedef unsigned short bf16;
typedef unsigned v4u __attribute__((ext_vector_type(4)));
typedef unsigned v2u __attribute__((ext_vector_type(2)));
typedef float f32x4 __attribute__((ext_vector_type(4)));
#define LDS_WAIT() asm volatile("s_waitcnt lgkmcnt(0)" ::: "memory")
__device__ __forceinline__ unsigned f2bf(float f) { unsigned u = __builtin_bit_cast(unsigned, f); return (u + 0x7fffu + ((u >> 16) & 1u)) >> 16; }
__device__ __forceinline__ unsigned pk2(float lo, float hi) { return f2bf(lo) | (f2bf(hi) << 16); }
__device__ __forceinline__ float bf_lo(unsigned w) { return __builtin_bit_cast(float, w << 16); }
__device__ __forceinline__ float bf_hi(unsigned w) { return __builtin_bit_cast(float, w & 0xffff0000u); }
__device__ __forceinline__ float bf2f(bf16 b) { return __builtin_bit_cast(float, (unsigned)b << 16); }
__device__ __forceinline__ float silu(float x) { return x / (1.0f + __expf(-x)); }
__device__ __forceinline__ float softplus(float x) { return x > 20.f ? x : log1pf(__expf(x)); }
__device__ __forceinline__ float wave_sum(float v) {
#pragma unroll
    for (int o = 1; o < 64; o <<= 1) v += __shfl_xor(v, o);
    return v;
}
#define XB_TMO      128
#define XB_XCNT(j)  (256  + 64 * (j))
#define XB_XSUB(j)  (1280 + 64 * (j))
#define XB_XGEN(j)  (2304 + 64 * (j))
#define XB_TOP      3328
#define XB_TOPGEN   3392
#define XCD_BAR_WORDS 3456
#define XB_SPIN_CAP (1u << 18)

__device__ __forceinline__ unsigned xb_ld(unsigned* p)              { return __hip_atomic_load(p, __ATOMIC_RELAXED, __HIP_MEMORY_SCOPE_AGENT); }
__device__ __forceinline__ unsigned xb_add(unsigned* p, unsigned v) { return __hip_atomic_fetch_add(p, v, __ATOMIC_RELAXED, __HIP_MEMORY_SCOPE_AGENT); }
__device__ __forceinline__ unsigned xb_xcc_id() { return (unsigned)__builtin_amdgcn_s_getreg((3 << 11) | 20) & 0xFu; }
#define XB_SPIN(cond, bar) do { unsigned _sp = 0; while (cond) { __builtin_amdgcn_s_sleep(1); \
    if ((++_sp & 255u) == 0u) { if (xb_ld(&(bar)[XB_TMO])) break; if (_sp > XB_SPIN_CAP) { atomicAdd(&(bar)[XB_TMO], 1u); break; } } } } while (0)

struct XcdBarrier {
    unsigned* bar; unsigned x;
    volatile LAS unsigned* st;
};

__device__ __forceinline__ XcdBarrier xcd_barrier_post(unsigned* bar, volatile LAS unsigned* st) {
    XcdBarrier b; b.bar = bar; b.x = xb_xcc_id(); b.st = st;
    if (threadIdx.x == 0) (void)xb_add(&bar[XB_XCNT(b.x)], 1u);
    return b;
}
__device__ __forceinline__ void xcd_barrier_complete(unsigned* bar, unsigned x, unsigned& nloc, unsigned& nx) {
    const unsigned G = gridDim.x * gridDim.y * gridDim.z;
    unsigned sum, cnt, mine, sp = 0u;
    for (;;) {
        sum = 0u; cnt = 0u; mine = 0u;
#pragma unroll
        for (unsigned j = 0; j < 16; ++j) { const unsigned c = xb_ld(&bar[XB_XCNT(j)]); sum += c; cnt += (c > 0u) ? 1u : 0u; mine = (j == x) ? c : mine; }
        if (sum == G) break;
        __builtin_amdgcn_s_sleep(1);
        if ((++sp & 255u) == 0u) { if (xb_ld(&bar[XB_TMO])) break; if (sp > XB_SPIN_CAP) { atomicAdd(&bar[XB_TMO], 1u); break; } }
    }
    nloc = mine > 0u ? mine : 1u; nx = cnt > 0u ? cnt : 1u;
}

__device__ __forceinline__ void xcd_barrier(const XcdBarrier& b) {
    asm volatile("s_waitcnt vmcnt(0)" ::: "memory");
    __syncthreads();
    if (threadIdx.x == 0) {
        unsigned* bar = b.bar;
        __builtin_amdgcn_s_waitcnt(0);
        unsigned nloc = b.st[0], nx = b.st[1];
        if (nloc == 0u) { xcd_barrier_complete(bar, b.x, nloc, nx); b.st[0] = nloc; b.st[1] = nx; }
        const unsigned old = xb_add(&bar[XB_XSUB(b.x)], 1u);
        const unsigned gen = old / nloc;
        if (old + 1u == (gen + 1u) * nloc) {
            __builtin_amdgcn_fence(__ATOMIC_RELEASE, "agent");
            asm volatile("s_waitcnt vmcnt(0)" ::: "memory");
            const unsigned og = xb_add(&bar[XB_TOP], 1u);
            const unsigned tg = og / nx;
            if (og + 1u == (tg + 1u) * nx) xb_add(&bar[XB_TOPGEN], 1u);
            else XB_SPIN(xb_ld(&bar[XB_TOPGEN]) == tg, bar);
            __builtin_amdgcn_fence(__ATOMIC_ACQUIRE, "agent");
            xb_add(&bar[XB_XGEN(b.x)], 1u);
            asm volatile("s_waitcnt vmcnt(0)" ::: "memory");
        } else {
            XB_SPIN(xb_ld(&bar[XB_XGEN(b.x)]) == gen, bar);
            __builtin_amdgcn_fence(__ATOMIC_ACQUIRE, "agent");
            asm volatile("s_waitcnt vmcnt(0)" ::: "memory");
        }
    }
    __syncthreads();
}

struct Ctx { int tid, lane, wave, G, vcu, gw, NGW, gtid, NT; };

__device__ __forceinline__ void tr_load(f32x4 (&v)[8], const float* W, int Nsrc, int n0, int k0, int lane) {
    const int n = n0 + 4 * (lane & 7); const bool ok = n < Nsrc; const float* p = W + (size_t)(k0 + 8 * (lane >> 3)) * Nsrc + n;
#pragma unroll
    for (int r = 0; r < 8; ++r) v[r] = ok ? *(const f32x4*)(p + (size_t)r * Nsrc) : (f32x4){0.f, 0.f, 0.f, 0.f};
}
__device__ __forceinline__ void tr_store(const f32x4 (&v)[8], bf16* WT, int K, int d0, int k0, int lane) {
    bf16* q = WT + (size_t)(d0 + 4 * (lane & 7)) * K + k0 + 8 * (lane >> 3);
#pragma unroll
    for (int j = 0; j < 4; ++j) { v4u o; o.x = pk2(v[0][j], v[1][j]); o.y = pk2(v[2][j], v[3][j]); o.z = pk2(v[4][j], v[5][j]); o.w = pk2(v[6][j], v[7][j]); *(v4u*)(q + (size_t)j * K) = o; }
}
template <int MODE> __device__ __forceinline__ int tr_src_col(int d0) { if (MODE == 1) { const int pn = d0 >> 8, bj = (d0 >> 7) & 1, j0 = d0 & 127; return bj * DFF + 128 * pn + j0; } return d0; }
template <int MODE> __device__ __forceinline__ void convert_matrix(const Ctx& c, const float* W, int K, int Nsrc, int Ndst, bf16* WT) {
    const int nblk = Ndst / 32, nitems = (K / 64) * nblk;
    constexpr int U = 4;
    for (int it0 = c.gw; it0 < nitems; it0 += U * c.NGW) {
        f32x4 v[U][8];
#pragma unroll
        for (int u = 0; u < U; ++u) { const int it = it0 + u * c.NGW; if (it < nitems) { const int kb = it / nblk, nb = it % nblk; tr_load(v[u], W, Nsrc, tr_src_col<MODE>(32 * nb), 64 * kb, c.lane); } }
#pragma unroll
        for (int u = 0; u < U; ++u) { const int it = it0 + u * c.NGW; if (it < nitems) { const int kb = it / nblk, nb = it % nblk; tr_store(v[u], WT, K, 32 * nb, 64 * kb, c.lane); } }
    }
}

template <bool OUT_BF16> __device__ __forceinline__ void rmsnorm_rows(const Ctx& c, const float* X, const float* gain, void* out) {
    for (int m = c.gw; m < SEQ; m += c.NGW) {
        const f32x4* xr = (const f32x4*)(X + (size_t)m * DM) + c.lane;
        f32x4 v[8]; float s = 0.f;
#pragma unroll
        for (int j = 0; j < 8; ++j) { v[j] = xr[64 * j]; s += (v[j].x * v[j].x + v[j].y * v[j].y) + (v[j].z * v[j].z + v[j].w * v[j].w); }
        const float rs = rsqrtf(wave_sum(s) * (1.f / DM) + EPS);
        const f32x4* gr = (const f32x4*)gain + c.lane;
#pragma unroll
        for (int j = 0; j < 8; ++j) { const f32x4 g = gr[64 * j]; const f32x4 o = v[j] * rs * g;
            if (OUT_BF16) { v2u w; w.x = pk2(o.x, o.y); w.y = pk2(o.z, o.w); *((v2u*)((bf16*)out + (size_t)m * DM) + c.lane + 64 * j) = w; }
            else *((f32x4*)((float*)out + (size_t)m * DM) + c.lane + 64 * j) = o; }
    }
}

__device__ __forceinline__ void ssd_conv_dt(const Ctx& c, const bf16* ZX, const float* cw, const float* cb, const float* DTR, const float* dtb, bf16* XC, float* DT) {
    constexpr int NV = S_CONVD / 8, RB = 8;
    for (int it = c.gtid; it < (SEQ / RB) * NV; it += c.NT) {
        const int tb = (it / NV) * RB, ch = (it % NV) * 8;
        f32x4 w[8]; float bias[8];
#pragma unroll
        for (int j = 0; j < 8; ++j) { w[j] = *(const f32x4*)(cw + (size_t)(ch + j) * 4); bias[j] = cb[ch + j]; }
        v4u x[RB + 3];
#pragma unroll
        for (int r = 0; r < RB + 3; ++r) { const int ts = tb - 3 + r; x[r] = (ts >= 0) ? *(const v4u*)(ZX + (size_t)ts * S_ZX + S_DI + ch) : (v4u){0u, 0u, 0u, 0u}; }
#pragma unroll
        for (int r = 0; r < RB; ++r) { float a[8];
#pragma unroll
            for (int j = 0; j < 8; ++j) a[j] = bias[j];
#pragma unroll
            for (int k = 0; k < 4; ++k) { const unsigned xw[4] = {x[r + k].x, x[r + k].y, x[r + k].z, x[r + k].w};
#pragma unroll
                for (int j = 0; j < 4; ++j) { a[2 * j] += bf_lo(xw[j]) * w[2 * j][k]; a[2 * j + 1] += bf_hi(xw[j]) * w[2 * j + 1][k]; } }
            v4u o; o.x = pk2(silu(a[0]), silu(a[1])); o.y = pk2(silu(a[2]), silu(a[3])); o.z = pk2(silu(a[4]), silu(a[5])); o.w = pk2(silu(a[6]), silu(a[7]));
            *(v4u*)(XC + (size_t)(tb + r) * S_CONVD + ch) = o; }
    }
    for (int it = c.gtid; it < SEQ * 64; it += c.NT) DT[it] = softplus(DTR[it] + dtb[it & 63]);
}
__device__ __forceinline__ void ssd_scan_naive(const Ctx& c, const bf16* XC, const bf16* ZX, const float* DT, const float* a_log, const float* dskip, float* YG) {
    for (int item = c.gw; item < S_NH * S_P; item += c.NGW) {
        const int h = item >> 6, p = item & 63, g = h >> 3;
        const float a = -__expf(a_log[h]), Dh = dskip[h];
        float s0 = 0.f, s1 = 0.f;
        const bf16* xcol = XC + h * 64 + p; const bf16* bcol = XC + S_DI + g * S_N + 2 * c.lane; const bf16* ccol = XC + S_DI + S_G * S_N + g * S_N + 2 * c.lane;
        const bf16* zcol = ZX + h * 64 + p; const float* dtp = DT + h;
        for (int t0 = 0; t0 < SEQ; t0 += 8) {
            float dtv[8], xv[8], zv[8]; unsigned bb[8], cc[8];
#pragma unroll
            for (int j = 0; j < 8; ++j) { const size_t t = t0 + j; dtv[j] = dtp[t * 64]; xv[j] = bf2f(xcol[t * S_CONVD]); zv[j] = bf2f(zcol[t * S_ZX]);
                bb[j] = *(const unsigned*)(bcol + t * S_CONVD); cc[j] = *(const unsigned*)(ccol + t * S_CONVD); }
#pragma unroll
            for (int j = 0; j < 8; ++j) { const float dA = __expf(dtv[j] * a), xd = dtv[j] * xv[j];
                s0 = s0 * dA + xd * bf_lo(bb[j]); s1 = s1 * dA + xd * bf_hi(bb[j]);
                const float y = wave_sum(bf_lo(cc[j]) * s0 + bf_hi(cc[j]) * s1) + Dh * xv[j];
                if (c.lane == 0) YG[(size_t)(t0 + j) * S_DI + h * 64 + p] = y * silu(zv[j]); }
        }
    }
}
__device__ __forceinline__ void ssd_groupnorm(const Ctx& c, const float* YG, const float* nw, bf16* MIX) {
    for (int it = c.gw; it < SEQ * S_G; it += c.NGW) {
        const size_t off = (size_t)it * 512 + 8 * c.lane; const int col = (it & 7) * 512 + 8 * c.lane;
        const f32x4 a = *(const f32x4*)(YG + off), b = *(const f32x4*)(YG + off + 4);
        const float ss = (a.x * a.x + a.y * a.y) + (a.z * a.z + a.w * a.w) + (b.x * b.x + b.y * b.y) + (b.z * b.z + b.w * b.w);
        const float rs = rsqrtf(wave_sum(ss) * (1.f / 512.f) + EPS);
        const f32x4 wa = *(const f32x4*)(nw + col), wb = *(const f32x4*)(nw + col + 4);
        v4u o; o.x = pk2(a.x * rs * wa.x, a.y * rs * wa.y); o.y = pk2(a.z * rs * wa.z, a.w * rs * wa.w); o.z = pk2(b.x * rs * wb.x, b.y * rs * wb.y); o.w = pk2(b.z * rs * wb.z, b.w * rs * wb.w);
        *(v4u*)(MIX + off) = o;
    }
}

__device__ __forceinline__ void gla_gate(const Ctx& c, const float* GL, const float* w2, const float* bg, float* AG) {
    for (int it = c.gtid; it < SEQ * G_DK; it += c.NT) {
        const int t = it >> 10, cc = it & 1023; float x = bg[cc];
#pragma unroll
        for (int r = 0; r < 16; ++r) x += GL[t * 16 + r] * w2[r * G_DK + cc];
        const float ls = -softplus(-x);
        AG[it] = __expf(ls * (1.f / 16.f));
    }
}
__device__ __forceinline__ void gla_scan_naive(const Ctx& c, const bf16* QKVR, const float* AG, float* OG) {
    for (int item = c.gw; item < G_H * G_HV; item += c.NGW) {
        const int h = item >> 9, v = item & 511;
        float S0 = 0.f, S1 = 0.f, S2 = 0.f, S3 = 0.f;
        const float* ap = AG + h * G_HK + 4 * c.lane; const bf16* qp = QKVR + h * G_HK + 4 * c.lane; const bf16* kp = QKVR + G_DK + h * G_HK + 4 * c.lane; const bf16* vp = QKVR + 2 * G_DK + h * G_HV + v;
        for (int t0 = 0; t0 < SEQ; t0 += 4) {
            f32x4 a4[4]; v2u k4[4], q4[4]; float vv[4];
#pragma unroll
            for (int j = 0; j < 4; ++j) { const size_t t = t0 + j; a4[j] = *(const f32x4*)(ap + t * G_DK); k4[j] = *(const v2u*)(kp + t * G_QKVR); q4[j] = *(const v2u*)(qp + t * G_QKVR); vv[j] = bf2f(vp[t * G_QKVR]); }
#pragma unroll
            for (int j = 0; j < 4; ++j) {
                S0 = S0 * a4[j].x + bf_lo(k4[j].x) * vv[j]; S1 = S1 * a4[j].y + bf_hi(k4[j].x) * vv[j]; S2 = S2 * a4[j].z + bf_lo(k4[j].y) * vv[j]; S3 = S3 * a4[j].w + bf_hi(k4[j].y) * vv[j];
                const float o = wave_sum((bf_lo(q4[j].x) * S0 + bf_hi(q4[j].x) * S1) + (bf_lo(q4[j].y) * S2 + bf_hi(q4[j].y) * S3)) * (1.f / 16.f);
                if (c.lane == 0) OG[(size_t)(t0 + j) * G_DV + h * G_HV + v] = o; }
        }
    }
}
__device__ __forceinline__ void gla_outnorm(const Ctx& c, const float* OG, const bf16* QKVR, const float* nw, bf16* MIX) {
    for (int it = c.gw; it < SEQ * G_H; it += c.NGW) {
        const int t = it >> 2, h = it & 3; const size_t off = (size_t)it * 512 + 8 * c.lane;
        const f32x4 a = *(const f32x4*)(OG + off), b = *(const f32x4*)(OG + off + 4);
        const float ss = (a.x * a.x + a.y * a.y) + (a.z * a.z + a.w * a.w) + (b.x * b.x + b.y * b.y) + (b.z * b.z + b.w * b.w);
        const float rs = rsqrtf(wave_sum(ss) * (1.f / 512.f) + EPS);
        const f32x4 wa = *(const f32x4*)(nw + 8 * c.lane), wb = *(const f32x4*)(nw + 8 * c.lane + 4);
        const v4u r = *(const v4u*)(QKVR + (size_t)t * G_QKVR + 2 * G_DK + G_DV + h * G_HV + 8 * c.lane);
        v4u o; o.x = pk2(a.x * rs * wa.x * silu(bf_lo(r.x)), a.y * rs * wa.y * silu(bf_hi(r.x))); o.y = pk2(a.z * rs * wa.z * silu(bf_lo(r.y)), a.w * rs * wa.w * silu(bf_hi(r.y)));
        o.z = pk2(b.x * rs * wb.x * silu(bf_lo(r.z)), b.y * rs * wb.y * silu(bf_hi(r.z))); o.w = pk2(b.z * rs * wb.z * silu(bf_lo(r.w)), b.w * rs * wb.w * silu(bf_hi(r.w)));
        *(v4u*)(MIX + off) = o;
    }
}

__device__ __forceinline__ void sgu_rstd(const Ctx& c, const bf16* ZZ, float* RS) {
    for (int t = c.gw; t < SEQ; t += c.NGW) {
        const v4u* p = (const v4u*)(ZZ + (size_t)t * 8192 + U_W) + c.lane; float s = 0.f;
#pragma unroll
        for (int j = 0; j < 8; ++j) { const v4u x = p[64 * j]; const unsigned w[4] = {x.x, x.y, x.z, x.w};
#pragma unroll
            for (int i = 0; i < 4; ++i) { const float lo = bf_lo(w[i]), hi = bf_hi(w[i]); s += lo * lo + hi * hi; } }
        s = wave_sum(s);
        if (c.lane == 0) RS[t] = rsqrtf(s * (1.f / U_W) + EPS);
    }
}
__device__ __forceinline__ void sgu_mix_naive(const Ctx& c, const bf16* ZZ, const float* RS, const float* WS, const float* BS, const float* nw, bf16* MIX) {
    for (int it = c.gw; it < SEQ * U_G; it += c.NGW) {
        const int g = it & 7, t = it >> 3, c0 = t & ~127, tt = t & 127;
        float acc[8];
#pragma unroll
        for (int j = 0; j < 8; ++j) acc[j] = 0.f;
        const float* wrow = WS + (size_t)g * 16384 + tt * 128;
        for (int s = 0; s <= tt; ++s) { const float w = wrow[s] * RS[c0 + s];
            const v4u x = *(const v4u*)(ZZ + (size_t)(c0 + s) * 8192 + U_W + g * 512 + 8 * c.lane); const unsigned xw[4] = {x.x, x.y, x.z, x.w};
#pragma unroll
            for (int j = 0; j < 4; ++j) { acc[2 * j] += w * bf_lo(xw[j]); acc[2 * j + 1] += w * bf_hi(xw[j]); } }
        const v4u uu = *(const v4u*)(ZZ + (size_t)t * 8192 + g * 512 + 8 * c.lane); const unsigned uw[4] = {uu.x, uu.y, uu.z, uu.w};
        const float b = BS[g * 128 + tt]; const float* nwp = nw + g * 512 + 8 * c.lane;
        v4u o; unsigned ow[4];
#pragma unroll
        for (int j = 0; j < 4; ++j) ow[j] = pk2(bf_lo(uw[j]) * (acc[2 * j] * nwp[2 * j] + b), bf_hi(uw[j]) * (acc[2 * j + 1] * nwp[2 * j + 1] + b));
        o.x = ow[0]; o.y = ow[1]; o.z = ow[2]; o.w = ow[3];
        *(v4u*)(MIX + (size_t)t * U_W + g * 512 + 8 * c.lane) = o;
    }
}
typedef short bf16x8 __attribute__((ext_vector_type(8)));
typedef short s16x4 __attribute__((ext_vector_type(4)));
#define MFMA16(a, b, c) __builtin_amdgcn_mfma_f32_16x16x32_bf16((a), (b), (c), 0, 0, 0)
__device__ __forceinline__ bf16x8 frag_rm(const LAS unsigned char* base, int pitch, int r0, int k0, int lane) {
    return *(const LAS bf16x8*)(base + (r0 + (lane & 15)) * pitch + (k0 + 8 * (lane >> 4)) * 2);
}
__device__ __forceinline__ bf16x8 frag_tr(const LAS unsigned char* base, int pitch, int k0, int c0, int lane) {
    const int g = lane >> 4, q = (lane & 15) >> 2, p = lane & 3;
    const LAS unsigned char* a = base + (k0 + 8 * g + q) * pitch + (c0 + 4 * p) * 2;
    const s16x4 lo = __builtin_amdgcn_ds_read_tr16_b64_v4i16((LAS s16x4*)a);
    const s16x4 hi = __builtin_amdgcn_ds_read_tr16_b64_v4i16((LAS s16x4*)(a + 4 * pitch));
    return (bf16x8){lo[0], lo[1], lo[2], lo[3], hi[0], hi[1], hi[2], hi[3]};
}
__device__ __forceinline__ bf16x8 frag_gl(const bf16* T, size_t ld, int c0, int k0, int lane) {
    return *(const bf16x8*)(T + (size_t)(c0 + (lane & 15)) * ld + k0 + 8 * (lane >> 4));
}
constexpr int QT_PITCH = 144, QT_BYTES = 32 * QT_PITCH;
__device__ __forceinline__ void stage_qtile(LAS unsigned char* xt, const bf16* src, size_t ld, int lane) {
    v4u x[4];
#pragma unroll
    for (int i = 0; i < 4; ++i) x[i] = *(const v4u*)(src + (size_t)((lane >> 3) + 8 * i) * ld + 8 * (lane & 7));
#pragma unroll
    for (int i = 0; i < 4; ++i) *(LAS v4u*)(xt + ((lane >> 3) + 8 * i) * QT_PITCH + 16 * (lane & 7)) = x[i];
}

__device__ __forceinline__ int opaque_v(int x) { asm volatile("" : "+v"(x)); return x; }

__device__ __forceinline__ void sgu_mix(const Ctx& c_, LAS unsigned char* lds, const bf16* ZZ, const float* RS, const float* WS, const float* BS, const float* nw, bf16* MIX) {
    constexpr int WP = 272;
    LAS unsigned char* Wt = lds; LAS unsigned char* xt = lds + 128 * WP + c_.wave * QT_BYTES;
    for (int unit = c_.vcu; unit < (SEQ / U_Q) * U_G; unit += c_.G) {
        const int g = unit & 7, t0 = (unit >> 3) * U_Q;
        Ctx c = c_; c.lane = opaque_v(c_.lane); c.tid = opaque_v(c_.tid);
        for (int it = c.tid; it < 128 * 16; it += NWAVES * 64) {
            const int t = it >> 4, s8 = (it & 15) * 8;
            const f32x4 w0 = *(const f32x4*)(WS + (size_t)g * 16384 + t * 128 + s8), w1 = *(const f32x4*)(WS + (size_t)g * 16384 + t * 128 + s8 + 4);
            const f32x4 r0 = *(const f32x4*)(RS + t0 + s8), r1 = *(const f32x4*)(RS + t0 + s8 + 4);
            float v[8] = {w0.x * r0.x, w0.y * r0.y, w0.z * r0.z, w0.w * r0.w, w1.x * r1.x, w1.y * r1.y, w1.z * r1.z, w1.w * r1.w};
#pragma unroll
            for (int j = 0; j < 8; ++j) v[j] = (s8 + j <= t) ? v[j] : 0.f;
            v4u o; o.x = pk2(v[0], v[1]); o.y = pk2(v[2], v[3]); o.z = pk2(v[4], v[5]); o.w = pk2(v[6], v[7]);
            *(LAS v4u*)(Wt + t * WP + s8 * 2) = o;
        }
        __syncthreads();
        const int d0 = g * U_GD + c.wave * 64;
        f32x4 acc[8][4];
#pragma unroll
        for (int a = 0; a < 8; ++a)
#pragma unroll
            for (int b = 0; b < 4; ++b) acc[a][b] = (f32x4){0.f, 0.f, 0.f, 0.f};
#pragma unroll
        for (int ks = 0; ks < 4; ++ks) {
            stage_qtile(xt, ZZ + (size_t)(t0 + 32 * ks) * (2 * U_W) + U_W + d0, 2 * U_W, c.lane);
            bf16x8 bfr[4];
#pragma unroll
            for (int dt = 0; dt < 4; ++dt) bfr[dt] = frag_tr(xt, QT_PITCH, 0, 16 * dt, c.lane);
#pragma unroll
            for (int tt = 2 * ks; tt < 8; ++tt) {
                const bf16x8 a = frag_rm(Wt, WP, 16 * tt, 32 * ks, c.lane);
#pragma unroll
                for (int dt = 0; dt < 4; ++dt) acc[tt][dt] = MFMA16(a, bfr[dt], acc[tt][dt]);
            }
        }
        const int gq = c.lane >> 4, r = c.lane & 15;
#pragma unroll
        for (int tt = 0; tt < 8; ++tt)
#pragma unroll
            for (int i = 0; i < 4; ++i) { const int tl = 16 * tt + 4 * gq + i; const size_t t = t0 + tl; const float b = BS[g * 128 + tl];
#pragma unroll
                for (int dt = 0; dt < 4; ++dt) { const int col = d0 + 16 * dt + r;
                    const float u = bf2f(ZZ[t * (2 * U_W) + col]);
                    MIX[t * U_W + col] = (bf16)f2bf(u * (acc[tt][dt][i] * nw[col] + b)); } }
        __syncthreads();
    }
}
__device__ __forceinline__ float wave_incl_scan(float x, int lane) {
#pragma unroll
    for (int o = 1; o < 64; o <<= 1) { const float n = __shfl_up(x, o); if (lane >= o) x += n; }
    return x;
}
__device__ __forceinline__ float ssd_dt_acum(const float* DT, const float* a_log, int t0, int h, int lane, LAS float* AC, LAS float* DTL) {
    const float a = -__expf(a_log[h]);
    const float d0 = DT[(size_t)(t0 + 2 * lane) * 64 + h], d1 = DT[(size_t)(t0 + 2 * lane + 1) * 64 + h];
    const float e0 = d0 * a, e1 = d1 * a;
    const float incl = wave_incl_scan(e0 + e1, lane);
    AC[2 * lane] = incl - e1; AC[2 * lane + 1] = incl; DTL[2 * lane] = d0; DTL[2 * lane + 1] = d1;
    return __shfl(incl, 63);
}
constexpr int SS_TP = 272, SS_TILE = 128 * SS_TP;

__device__ __forceinline__ void ssd_states(const Ctx& c_, LAS unsigned char* lds, const bf16* XC, const float* DT, const float* a_log, float* ST, float* CD) {
    LAS unsigned char* Bt = lds; LAS unsigned char* xt = lds + SS_TILE + c_.wave * QT_BYTES;
    LAS float* AC = (LAS float*)(lds + SS_TILE + 8 * QT_BYTES + c_.wave * 1024); LAS float* DTL = AC + 128;
    for (int unit = c_.vcu; unit < (SEQ / 128) * S_G; unit += c_.G) {
        Ctx c = c_; c.lane = opaque_v(c_.lane); c.tid = opaque_v(c_.tid);
        const int g = unit & 7, cc = unit >> 3, t0 = cc * 128, h = g * 8 + c.wave;
        for (int it = c.tid; it < 128 * 16; it += NWAVES * 64) { const int row = it >> 4, ch = it & 15;
            *(LAS v4u*)(Bt + row * SS_TP + ch * 16) = *(const v4u*)(XC + (size_t)(t0 + row) * S_CONVD + S_DI + g * S_N + ch * 8); }
        const float aend = ssd_dt_acum(DT, a_log, t0, h, c.lane, AC, DTL);
        if (c.lane == 0) CD[cc * 64 + h] = __expf(aend);
        __syncthreads();
        f32x4 acc[4][8];
#pragma unroll
        for (int a = 0; a < 4; ++a)
#pragma unroll
            for (int b = 0; b < 8; ++b) acc[a][b] = (f32x4){0.f, 0.f, 0.f, 0.f};
#pragma unroll
        for (int ks = 0; ks < 4; ++ks) {
            {
                v4u x[4];
#pragma unroll
                for (int i = 0; i < 4; ++i) x[i] = *(const v4u*)(XC + (size_t)(t0 + 32 * ks + (c.lane >> 3) + 8 * i) * S_CONVD + h * 64 + 8 * (c.lane & 7));
#pragma unroll
                for (int i = 0; i < 4; ++i) { const int s = 32 * ks + (c.lane >> 3) + 8 * i; const float w = DTL[s] * __expf(aend - AC[s]);
                    v4u o; o.x = pk2(bf_lo(x[i].x) * w, bf_hi(x[i].x) * w); o.y = pk2(bf_lo(x[i].y) * w, bf_hi(x[i].y) * w); o.z = pk2(bf_lo(x[i].z) * w, bf_hi(x[i].z) * w); o.w = pk2(bf_lo(x[i].w) * w, bf_hi(x[i].w) * w);
                    *(LAS v4u*)(xt + ((c.lane >> 3) + 8 * i) * QT_PITCH + 16 * (c.lane & 7)) = o; }
            }
            bf16x8 afr[4];
#pragma unroll
            for (int pt = 0; pt < 4; ++pt) afr[pt] = frag_tr(xt, QT_PITCH, 0, 16 * pt, c.lane);
#pragma unroll
            for (int nt = 0; nt < 8; ++nt) { const bf16x8 b = frag_tr(Bt, SS_TP, 32 * ks, 16 * nt, c.lane);
#pragma unroll
                for (int pt = 0; pt < 4; ++pt) acc[pt][nt] = MFMA16(afr[pt], b, acc[pt][nt]); }
        }
        float* stb = ST + ((size_t)(cc * 64 + h) * 64) * 128;
        const int gq = c.lane >> 4, r = c.lane & 15;
#pragma unroll
        for (int pt = 0; pt < 4; ++pt)
#pragma unroll
            for (int i = 0; i < 4; ++i)
#pragma unroll
                for (int nt = 0; nt < 8; ++nt) { stb[(16 * pt + 4 * gq + i) * 128 + 16 * nt + r] = acc[pt][nt][i]; if (nt == 7) asm volatile("" ::: "memory"); }
        __syncthreads();
    }
}
__device__ __forceinline__ void ssd_chunk_scan(const Ctx& c, const float* ST, const float* CD, bf16* PV) {
    constexpr int NV = 64 * 64 * 128 / 4, CS = 64 * 64 * 128;
    for (int idx = c.gtid; idx < NV; idx += c.NT) {
        const int h = idx >> 11; f32x4 st = (f32x4){0.f, 0.f, 0.f, 0.f};
        for (int c0 = 0; c0 < 64; c0 += 8) {
            f32x4 s[8]; float d[8];
#pragma unroll
            for (int j = 0; j < 8; ++j) { s[j] = *(const f32x4*)(ST + (size_t)(c0 + j) * CS + (size_t)idx * 4); d[j] = CD[(c0 + j) * 64 + h]; }
#pragma unroll
            for (int j = 0; j < 8; ++j) { v2u o; o.x = pk2(st.x, st.y); o.y = pk2(st.z, st.w); *(v2u*)(PV + (size_t)(c0 + j) * CS + (size_t)idx * 4) = o; st = st * d[j] + s[j]; }
        }
    }
}
__device__ __forceinline__ void ssd_out(const Ctx& c_, LAS unsigned char* lds, const bf16* XC, const bf16* ZX, const float* DT, const float* a_log, const float* dskip, const bf16* PV, const float* nw, bf16* MIX) {
    LAS unsigned char* Ct = lds; LAS unsigned char* Bt = lds + SS_TILE; LAS unsigned char* xt = lds + 2 * SS_TILE + c_.wave * QT_BYTES;
    LAS float* AC = (LAS float*)(lds + 2 * SS_TILE + 8 * QT_BYTES + c_.wave * 1024); LAS float* DTL = AC + 128;
    LAS float* RSS = (LAS float*)(lds + 2 * SS_TILE + 8 * QT_BYTES + 8 * 1024);
    for (int unit = c_.vcu; unit < (SEQ / 128) * S_G; unit += c_.G) {
        Ctx c = c_; c.lane = opaque_v(c_.lane); c.tid = opaque_v(c_.tid);
        const int gq = c.lane >> 4, r = c.lane & 15;
        const int g = unit & 7, cc = unit >> 3, t0 = cc * 128, h = g * 8 + c.wave;
        for (int it = c.tid; it < 128 * 16; it += NWAVES * 64) { const int row = it >> 4, ch = it & 15; const bf16* src = XC + (size_t)(t0 + row) * S_CONVD + S_DI + g * S_N + ch * 8;
            *(LAS v4u*)(Bt + row * SS_TP + ch * 16) = *(const v4u*)src; *(LAS v4u*)(Ct + row * SS_TP + ch * 16) = *(const v4u*)(src + S_G * S_N); }
        (void)ssd_dt_acum(DT, a_log, t0, h, c.lane, AC, DTL);
        const float Dh = dskip[h];
        __syncthreads();
        {
            f32x4 cb[8];
#pragma unroll
            for (int st = 0; st < 8; ++st) cb[st] = (f32x4){0.f, 0.f, 0.f, 0.f};
#pragma unroll
            for (int ks = 0; ks < 4; ++ks) { const bf16x8 a = frag_rm(Ct, SS_TP, 16 * c.wave, 32 * ks, c.lane);
#pragma unroll
                for (int st = 0; st < 8; ++st) if (st <= c.wave) { const bf16x8 b = frag_rm(Bt, SS_TP, 16 * st, 32 * ks, c.lane); cb[st] = MFMA16(a, b, cb[st]); } }
            __syncthreads();
#pragma unroll
            for (int st = 0; st < 8; ++st) if (st <= c.wave) {
#pragma unroll
                for (int i = 0; i < 4; ++i) *(LAS bf16*)(Bt + (16 * c.wave + 4 * gq + i) * SS_TP + (16 * st + r) * 2) = (bf16)f2bf(cb[st][i]); }
            __syncthreads();
        }
#pragma unroll 1
        for (int hb = 0; hb < 2; ++hb) {
        Ctx c = c_; c.lane = opaque_v(c_.lane);
        const int gq = c.lane >> 4, r = c.lane & 15;
        f32x4 acc[4][4];
#pragma unroll
        for (int a = 0; a < 4; ++a)
#pragma unroll
            for (int b = 0; b < 4; ++b) acc[a][b] = (f32x4){0.f, 0.f, 0.f, 0.f};
        {
            const bf16* pvb = PV + ((size_t)(cc * 64 + h) * 64) * 128;
#pragma unroll
            for (int ks = 0; ks < 4; ++ks) { bf16x8 bfr[4];
#pragma unroll
                for (int pt = 0; pt < 4; ++pt) bfr[pt] = frag_gl(pvb, 128, 16 * pt, 32 * ks, c.lane);
#pragma unroll
                for (int tl = 0; tl < 4; ++tl) { const bf16x8 a = frag_rm(Ct, SS_TP, 64 * hb + 16 * tl, 32 * ks, c.lane);
#pragma unroll
                    for (int pt = 0; pt < 4; ++pt) acc[tl][pt] = MFMA16(a, bfr[pt], acc[tl][pt]); } }
#pragma unroll
            for (int tl = 0; tl < 4; ++tl)
#pragma unroll
                for (int i = 0; i < 4; ++i) { const float e = __expf(AC[64 * hb + 16 * tl + 4 * gq + i]);
#pragma unroll
                    for (int pt = 0; pt < 4; ++pt) acc[tl][pt][i] *= e; }
        }
#pragma unroll
        for (int ks = 0; ks < 4; ++ks) if (ks < 2 * hb + 2) {
            stage_qtile(xt, XC + (size_t)(t0 + 32 * ks) * S_CONVD + h * 64, S_CONVD, c.lane);
            bf16x8 bfr[4];
#pragma unroll
            for (int pt = 0; pt < 4; ++pt) bfr[pt] = frag_tr(xt, QT_PITCH, 0, 16 * pt, c.lane);
            float acs[8], dts[8];
#pragma unroll
            for (int j = 0; j < 8; ++j) { acs[j] = AC[32 * ks + 8 * gq + j]; dts[j] = DTL[32 * ks + 8 * gq + j]; }
#pragma unroll
            for (int tl = 0; tl < 4; ++tl) if (4 * hb + tl >= 2 * ks) {
                const int trow = 64 * hb + 16 * tl + r; const float act = AC[trow];
                const v4u cw = *(const LAS v4u*)(Bt + trow * SS_TP + (32 * ks + 8 * gq) * 2);
                const float cbv[8] = {bf_lo(cw.x), bf_hi(cw.x), bf_lo(cw.y), bf_hi(cw.y), bf_lo(cw.z), bf_hi(cw.z), bf_lo(cw.w), bf_hi(cw.w)};
                float v[8];
#pragma unroll
                for (int j = 0; j < 8; ++j) { const int sj = 32 * ks + 8 * gq + j; float x = cbv[j] * __expf(act - acs[j]) * dts[j]; x = (sj <= trow) ? x : 0.f; v[j] = (sj == trow) ? x + Dh : x; }
                v4u aw; aw.x = pk2(v[0], v[1]); aw.y = pk2(v[2], v[3]); aw.z = pk2(v[4], v[5]); aw.w = pk2(v[6], v[7]);
                const bf16x8 a = __builtin_bit_cast(bf16x8, aw);
#pragma unroll
                for (int pt = 0; pt < 4; ++pt) acc[tl][pt] = MFMA16(a, bfr[pt], acc[tl][pt]);
            }
        }
#pragma unroll
        for (int tl = 0; tl < 4; ++tl)
#pragma unroll
            for (int i = 0; i < 4; ++i) { const int tr = 64 * hb + 16 * tl + 4 * gq + i; float ssq = 0.f;
#pragma unroll
                for (int pt = 0; pt < 4; ++pt) { const float z = bf2f(ZX[(size_t)(t0 + tr) * S_ZX + h * 64 + 16 * pt + r]); const float v = acc[tl][pt][i] * silu(z); acc[tl][pt][i] = v; ssq += v * v; }
                ssq += __shfl_xor(ssq, 1); ssq += __shfl_xor(ssq, 2); ssq += __shfl_xor(ssq, 4); ssq += __shfl_xor(ssq, 8);
                if (r == 0) RSS[c.wave * 128 + tr] = ssq; }
        __syncthreads();
#pragma unroll
        for (int tl = 0; tl < 4; ++tl)
#pragma unroll
            for (int i = 0; i < 4; ++i) { const int tr = 64 * hb + 16 * tl + 4 * gq + i; float tot = 0.f;
#pragma unroll
                for (int w = 0; w < 8; ++w) tot += RSS[w * 128 + tr];
                const float rs = rsqrtf(tot * (1.f / 512.f) + EPS);
#pragma unroll
                for (int pt = 0; pt < 4; ++pt) { const int col = h * 64 + 16 * pt + r; MIX[(size_t)(t0 + tr) * S_DI + col] = (bf16)f2bf(acc[tl][pt][i] * rs * nw[col]); } }
        }
        __syncthreads();
    }
}
__device__ __forceinline__ void gla_bcum(const Ctx& c, const float* GL, const float* w2, const float* bg, float* BC) {
    for (int idx = c.gtid; idx < (SEQ / 64) * G_DK; idx += c.NT) {
        const int cc = idx >> 10, col = idx & 1023; float w[16];
#pragma unroll
        for (int r = 0; r < 16; ++r) w[r] = w2[r * G_DK + col];
        const float b = bg[col]; float acc = 0.f;
        for (int t = 0; t < 64; ++t) { const f32x4* gp = (const f32x4*)(GL + (size_t)(cc * 64 + t) * 16); const f32x4 g0 = gp[0], g1 = gp[1], g2 = gp[2], g3 = gp[3];
            float x = b;
            x += g0.x * w[0] + g0.y * w[1] + g0.z * w[2] + g0.w * w[3]; x += g1.x * w[4] + g1.y * w[5] + g1.z * w[6] + g1.w * w[7];
            x += g2.x * w[8] + g2.y * w[9] + g2.z * w[10] + g2.w * w[11]; x += g3.x * w[12] + g3.y * w[13] + g3.z * w[14] + g3.w * w[15];
            acc += -softplus(-x) * (1.f / 16.f);
            BC[(size_t)(cc * 64 + t) * G_DK + col] = acc; }
    }
}
constexpr int GK_P = 528, GK_TILE = 64 * GK_P;
constexpr int GV_P = 144, GV_TILE = 64 * GV_P;
__device__ __forceinline__ v4u scale8(const v4u x, const f32x4 e0, const f32x4 e1) {
    v4u o; o.x = pk2(bf_lo(x.x) * e0.x, bf_hi(x.x) * e0.y); o.y = pk2(bf_lo(x.y) * e0.z, bf_hi(x.y) * e0.w); o.z = pk2(bf_lo(x.z) * e1.x, bf_hi(x.z) * e1.y); o.w = pk2(bf_lo(x.w) * e1.z, bf_hi(x.w) * e1.w); return o;
}
__device__ __forceinline__ f32x4 exp4(const f32x4 a) { return (f32x4){__expf(a.x), __expf(a.y), __expf(a.z), __expf(a.w)}; }
__device__ __forceinline__ void gla_states(const Ctx& c_, LAS unsigned char* lds, const bf16* QKVR, const float* BC, float* KV) {
    LAS unsigned char* Kt = lds; LAS unsigned char* vt = lds + GK_TILE + c_.wave * GV_TILE;
    for (int unit = c_.vcu; unit < (SEQ / 64) * G_H; unit += c_.G) {
        Ctx c = c_; c.lane = opaque_v(c_.lane); c.tid = opaque_v(c_.tid);
        const int h = unit & 3, cc = unit >> 2, t0 = cc * 64;
        for (int it = c.tid; it < 64 * 32; it += NWAVES * 64) { const int s = it >> 5, ch = it & 31;
            const v4u x = *(const v4u*)(QKVR + (size_t)(t0 + s) * G_QKVR + G_DK + h * G_HK + 8 * ch);
            const float* bs = BC + (size_t)(t0 + s) * G_DK + h * G_HK + 8 * ch; const float* be = BC + (size_t)(t0 + 63) * G_DK + h * G_HK + 8 * ch;
            const f32x4 e0 = exp4(*(const f32x4*)be - *(const f32x4*)bs), e1 = exp4(*(const f32x4*)(be + 4) - *(const f32x4*)(bs + 4));
            *(LAS v4u*)(Kt + s * GK_P + ch * 16) = scale8(x, e0, e1); }
        { const bf16* vsrc = QKVR + (size_t)t0 * G_QKVR + 2 * G_DK + h * G_HV + c.wave * 64;
          stage_qtile(vt, vsrc, G_QKVR, c.lane); stage_qtile(vt + 32 * GV_P, vsrc + (size_t)32 * G_QKVR, G_QKVR, c.lane); }
        __syncthreads();
#pragma unroll 1
        for (int kh = 0; kh < 2; ++kh) {
            const int lane = opaque_v(c.lane), gq = lane >> 4, r = lane & 15;
            f32x4 acc[4][8];
#pragma unroll
            for (int a = 0; a < 4; ++a)
#pragma unroll
                for (int b = 0; b < 8; ++b) acc[a][b] = (f32x4){0.f, 0.f, 0.f, 0.f};
#pragma unroll
            for (int ks = 0; ks < 2; ++ks) { bf16x8 afr[4];
#pragma unroll
                for (int v4 = 0; v4 < 4; ++v4) afr[v4] = frag_tr(vt, GV_P, 32 * ks, 16 * v4, lane);
#pragma unroll
                for (int kt = 0; kt < 8; ++kt) { const bf16x8 b = frag_tr(Kt, GK_P, 32 * ks, 128 * kh + 16 * kt, lane);
#pragma unroll
                    for (int v4 = 0; v4 < 4; ++v4) acc[v4][kt] = MFMA16(afr[v4], b, acc[v4][kt]); } }
            float* kvb = KV + ((size_t)(cc * 4 + h) * G_HV + c.wave * 64) * G_HK + 128 * kh;
#pragma unroll
            for (int v4 = 0; v4 < 4; ++v4)
#pragma unroll
                for (int i = 0; i < 4; ++i)
#pragma unroll
                    for (int kt = 0; kt < 8; ++kt) kvb[(size_t)(16 * v4 + 4 * gq + i) * G_HK + 16 * kt + r] = acc[v4][kt][i];
        }
        __syncthreads();
    }
}
__device__ __forceinline__ void gla_chunk_scan(const Ctx& c, const float* KV, const float* BC, bf16* SP) {
    constexpr int NV = G_H * G_HV * G_HK / 4, CS = G_H * G_HV * G_HK;
    for (int idx = c.gtid; idx < NV; idx += c.NT) {
        const int h = idx >> 15, k = (idx & 63) * 4; f32x4 st = (f32x4){0.f, 0.f, 0.f, 0.f};
        for (int c0 = 0; c0 < SEQ / 64; c0 += 8) {
            f32x4 s[8], d[8];
#pragma unroll
            for (int j = 0; j < 8; ++j) { s[j] = *(const f32x4*)(KV + (size_t)(c0 + j) * CS + (size_t)idx * 4); d[j] = *(const f32x4*)(BC + (size_t)((c0 + j) * 64 + 63) * G_DK + h * G_HK + k); }
#pragma unroll
            for (int j = 0; j < 8; ++j) { v2u o; o.x = pk2(st.x, st.y); o.y = pk2(st.z, st.w); *(v2u*)(SP + (size_t)(c0 + j) * CS + (size_t)idx * 4) = o; st = st * exp4(d[j]) + s[j]; }
        }
    }
}
__device__ __forceinline__ void gla_out(const Ctx& c_, LAS unsigned char* lds, const bf16* QKVR, const float* BC, const bf16* SP, const float* nw, bf16* MIX) {
    LAS unsigned char* Qt = lds; LAS unsigned char* Kt = lds + GK_TILE; LAS unsigned char* At = lds + 2 * GK_TILE; LAS unsigned char* vt = lds + 2 * GK_TILE + GV_TILE + c_.wave * GV_TILE;
    LAS float* RSS = (LAS float*)(lds + 2 * GK_TILE + 9 * GV_TILE);
    for (int unit = c_.vcu; unit < (SEQ / 64) * G_H; unit += c_.G) {
        Ctx c = c_; c.lane = opaque_v(c_.lane); c.tid = opaque_v(c_.tid);
        const int gq = c.lane >> 4, r = c.lane & 15;
        const int h = unit & 3, cc = unit >> 2, t0 = cc * 64;
        for (int it = c.tid; it < 64 * 32; it += NWAVES * 64) { const int s = it >> 5, ch = it & 31;
            const bf16* qp = QKVR + (size_t)(t0 + s) * G_QKVR + h * G_HK + 8 * ch;
            const v4u xq = *(const v4u*)qp, xk = *(const v4u*)(qp + G_DK);
            const float* bs = BC + (size_t)(t0 + s) * G_DK + h * G_HK + 8 * ch;
            const f32x4 b0 = *(const f32x4*)bs, b1 = *(const f32x4*)(bs + 4);
            *(LAS v4u*)(Qt + s * GK_P + ch * 16) = scale8(xq, exp4(b0) * (1.f / 16.f), exp4(b1) * (1.f / 16.f));
            *(LAS v4u*)(Kt + s * GK_P + ch * 16) = scale8(xk, exp4(-b0), exp4(-b1)); }
        { const bf16* vsrc = QKVR + (size_t)t0 * G_QKVR + 2 * G_DK + h * G_HV + c.wave * 64;
          stage_qtile(vt, vsrc, G_QKVR, c.lane); stage_qtile(vt + 32 * GV_P, vsrc + (size_t)32 * G_QKVR, G_QKVR, c.lane); }
        __syncthreads();
#pragma unroll 1
        for (int rep = 0; rep < 2; ++rep) {
            const int lane = opaque_v(c.lane), gq2 = lane >> 4, r2 = lane & 15;
            const int id = c.wave + 8 * rep, tt = id >> 2, st = id & 3;
            f32x4 a4 = (f32x4){0.f, 0.f, 0.f, 0.f};
            if (st <= tt) {
#pragma unroll
                for (int ks = 0; ks < 8; ++ks) a4 = MFMA16(frag_rm(Qt, GK_P, 16 * tt, 32 * ks, lane), frag_rm(Kt, GK_P, 16 * st, 32 * ks, lane), a4);
            }
#pragma unroll
            for (int i = 0; i < 4; ++i) { const int tr = 16 * tt + 4 * gq2 + i, sc = 16 * st + r2; *(LAS bf16*)(At + tr * GV_P + sc * 2) = (bf16)f2bf(sc <= tr ? a4[i] : 0.f); }
        }
        __syncthreads();
        f32x4 acc[4][4];
#pragma unroll
        for (int a = 0; a < 4; ++a)
#pragma unroll
            for (int b = 0; b < 4; ++b) acc[a][b] = (f32x4){0.f, 0.f, 0.f, 0.f};
#pragma unroll
        for (int ks = 0; ks < 2; ++ks) { bf16x8 bfr[4];
#pragma unroll
            for (int v4 = 0; v4 < 4; ++v4) bfr[v4] = frag_tr(vt, GV_P, 32 * ks, 16 * v4, c.lane);
#pragma unroll
            for (int tt = 2 * ks; tt < 4; ++tt) { const bf16x8 a = frag_rm(At, GV_P, 16 * tt, 32 * ks, c.lane);
#pragma unroll
                for (int v4 = 0; v4 < 4; ++v4) acc[tt][v4] = MFMA16(a, bfr[v4], acc[tt][v4]); } }
        { const bf16* spb = SP + ((size_t)(cc * 4 + h) * G_HV + c.wave * 64) * G_HK;
#pragma unroll
          for (int ks = 0; ks < 8; ++ks) { bf16x8 bfr[4];
#pragma unroll
            for (int v4 = 0; v4 < 4; ++v4) bfr[v4] = frag_gl(spb, G_HK, 16 * v4, 32 * ks, c.lane);
#pragma unroll
            for (int tt = 0; tt < 4; ++tt) { const bf16x8 a = frag_rm(Qt, GK_P, 16 * tt, 32 * ks, c.lane);
#pragma unroll
                for (int v4 = 0; v4 < 4; ++v4) acc[tt][v4] = MFMA16(a, bfr[v4], acc[tt][v4]); } } }
#pragma unroll
        for (int tt = 0; tt < 4; ++tt)
#pragma unroll
            for (int i = 0; i < 4; ++i) { float ssq = 0.f;
#pragma unroll
                for (int v4 = 0; v4 < 4; ++v4) ssq += acc[tt][v4][i] * acc[tt][v4][i];
                ssq += __shfl_xor(ssq, 1); ssq += __shfl_xor(ssq, 2); ssq += __shfl_xor(ssq, 4); ssq += __shfl_xor(ssq, 8);
                if (r == 0) RSS[c.wave * 64 + 16 * tt + 4 * gq + i] = ssq; }
        __syncthreads();
#pragma unroll
        for (int tt = 0; tt < 4; ++tt)
#pragma unroll
            for (int i = 0; i < 4; ++i) { const int tr = 16 * tt + 4 * gq + i; float tot = 0.f;
#pragma unroll
                for (int w = 0; w < 8; ++w) tot += RSS[w * 64 + tr];
                const float rs = rsqrtf(tot * (1.f / 512.f) + EPS);
#pragma unroll
                for (int v4 = 0; v4 < 4; ++v4) { const int vc = c.wave * 64 + 16 * v4 + r;
                    const float rg = bf2f(QKVR[(size_t)(t0 + tr) * G_QKVR + 2 * G_DK + G_DV + h * G_HV + vc]);
                    MIX[(size_t)(t0 + tr) * G_DV + h * G_HV + vc] = (bf16)f2bf(acc[tt][v4][i] * rs * nw[vc] * silu(rg)); } }
        __syncthreads();
    }
}
constexpr int NPH = 86, PH_FINAL = 85;
enum { KIND_SSD = 0, KIND_GLA = 1, KIND_SGU = 2, KIND_FFN = 3 };
__host__ __device__ inline int step_kind(int s) { return (s % 3 == 1) ? ((s / 3) % 3) : KIND_FFN; }
__host__ __device__ inline bool slot_used(int k) {
    if (k == 0 || k == PH_FINAL) return true;
    const int s = (k - 1) / 7, j = (k - 1) % 7, kind = step_kind(s);
    if (kind == KIND_FFN) return j <= 1 || j == 6;
    if (kind == KIND_SGU) return j <= 3 || j == 6;
    return true;
}
__device__ __forceinline__ int opaque_idx(int i) { asm volatile("" : "+s"(i)); return i; }
struct Args { const float* in[25]; float* out; unsigned char* ws; int ph_lo, ph_hi; };

__global__ void __launch_bounds__(NWAVES * 64, 2) mk_fwd(Args args) {
    extern __shared__ __attribute__((aligned(16))) unsigned char lds_raw[];
    LAS unsigned char* lds = (LAS unsigned char*)lds_raw;
    volatile LAS unsigned* MISC = (volatile LAS unsigned*)(lds + MISC_OFF);
    Ctx c0; c0.tid = threadIdx.x; c0.lane = c0.tid & 63; c0.wave = __builtin_amdgcn_readfirstlane(c0.tid >> 6);
    c0.G = gridDim.x; { const int bx = blockIdx.x; c0.vcu = (c0.G % 8 == 0) ? (bx % 8) * (c0.G / 8) + bx / 8 : bx; }
    c0.gw = c0.vcu * NWAVES + c0.wave; c0.NGW = c0.G * NWAVES; c0.gtid = c0.vcu * (NWAVES * 64) + c0.tid; c0.NT = c0.G * NWAVES * 64;
    unsigned char* ws = args.ws;
    unsigned* ctl = (unsigned*)(ws + WS_CTL);
    for (int u = c0.tid; u < (LDS_BYTES - LDSCTL_OFF) / 4; u += NWAVES * 64) ((LAS unsigned*)(lds + LDSCTL_OFF))[u] = 0u;
    __syncthreads();
    const int lo = args.ph_lo, hi = args.ph_hi;
    const bool fused = (hi - lo) > 1;
    XcdBarrier bar; bar.bar = ctl + CW_BAR; bar.x = 0; bar.st = nullptr;
    if (fused) bar = xcd_barrier_post(ctl + CW_BAR, MISC + 8);
#define IN(k) (lo <= (k) && (k) < hi)
#define SEAM() do { if (fused) xcd_barrier(bar); } while (0)
#define FRESH() Ctx c = c0; asm volatile("" : "+v"(c.tid), "+v"(c.lane), "+v"(c.gtid)); asm volatile("" : "+s"(c.gw), "+s"(c.NGW), "+s"(c.NT))
#define INP(i) (args.in[opaque_idx(i)])
#define REP(bit) for (int rep_ = 0; rep_ < ((PROBE_DUP >> (bit)) & 1) + 1; ++rep_)

    float* H = (float*)(ws + WS_H); bf16* HN = (bf16*)(ws + WS_HN); bf16* BIG = (bf16*)(ws + WS_BIG); bf16* MIX = (bf16*)(ws + WS_MIX);
    unsigned char* scr = ws + WS_SCR;

    if (IN(0)) REP(0) {
        FRESH();
        for (int i = 0; i < 8; ++i) {
            convert_matrix<1>(c, INP(2) + (size_t)i * DM * 2 * DFF, DM, 2 * DFF, 2 * DFF, (bf16*)(ws + WS_W_FFN_IN + i * SZ_FFN_IN));
            convert_matrix<0>(c, INP(3) + (size_t)i * DFF * DM, DFF, DM, DM, (bf16*)(ws + WS_W_FFN_OUT + i * SZ_FFN_OUT));
        }
        for (int i = 0; i < 2; ++i) {
            convert_matrix<0>(c, INP(5) + (size_t)i * DM * S_IN, DM, S_IN, S_INP, (bf16*)(ws + WS_W_SSD_IN + i * SZ_SSD_IN));
            convert_matrix<0>(c, INP(12) + (size_t)i * S_DI * DM, S_DI, DM, DM, (bf16*)(ws + WS_W_SSD_OUT + i * SZ_SSD_OUT));
        }
        convert_matrix<0>(c, INP(13), DM, G_IN, G_INP, (bf16*)(ws + WS_W_GLA_IN));
        convert_matrix<0>(c, INP(17), G_DV, DM, DM, (bf16*)(ws + WS_W_GLA_OUT));
        convert_matrix<0>(c, INP(18), DM, 2 * U_W, 2 * U_W, (bf16*)(ws + WS_W_SGU_IN));
        convert_matrix<0>(c, INP(23), U_W, DM, DM, (bf16*)(ws + WS_W_SGU_OUT));
        { const f32x4* src = (const f32x4*)INP(0); f32x4* dst = (f32x4*)H;
          for (int i = c.gtid; i < SEQ * DM / 4; i += c.NT) dst[i] = src[i]; }
        SEAM();
    }

    for (int s = 0; s < 3 * DEPTH; ++s) {
        const int base = 1 + 7 * s, layer = s / 3, sub = s % 3, kind = step_kind(s), mj = layer / 3, fi = layer * 2 + (sub >> 1);
        if (IN(base)) REP(1) {
            FRESH();
            const float* gain = (sub == 1) ? INP(4) + (size_t)layer * DM : INP(1) + (size_t)fi * DM;
            rmsnorm_rows<true>(c, H, gain, HN);
            SEAM();
        }
        if (IN(base + 1)) REP(3) {
            if (kind == KIND_FFN) {
                pg8::Gemm g{HN, (const bf16*)(ws + WS_W_FFN_IN + fi * SZ_FFN_IN), SEQ, 2 * DFF, DM}; pg8::StaticOrder S; S.init(SEQ, 2 * DFF, c0.G, (int)blockIdx.x);
                pg8::EpiSwiGLU E{BIG, DFF};
                pg8::gemm_phase<pg8::EpiSwiGLU, pg8::StaticOrder, true, true>(lds + RING_OFF, g, S, E);
            } else {
                const bf16* W = (const bf16*)(ws + (kind == KIND_SSD ? WS_W_SSD_IN + mj * SZ_SSD_IN : kind == KIND_GLA ? WS_W_GLA_IN : WS_W_SGU_IN));
                const int Np = kind == KIND_SSD ? S_INP : kind == KIND_GLA ? G_INP : 2 * U_W, ldo = kind == KIND_SSD ? S_ZX : kind == KIND_GLA ? G_QKVR : 2 * U_W;
                pg8::Gemm g{HN, W, SEQ, Np, DM}; pg8::StaticOrder S; S.init(SEQ, Np, c0.G, (int)blockIdx.x);
                pg8::EpiBf16X E{BIG, ldo, kind == KIND_SGU ? INP(19) : nullptr, ldo / 256, (float*)(scr + (kind == KIND_SSD ? SC_DTR : SC_GL)), kind == KIND_SSD ? 64 : 16};
                pg8::gemm_phase<pg8::EpiBf16X, pg8::StaticOrder, true, true>(lds + RING_OFF, g, S, E);
            }
            SEAM();
        }
        if (kind == KIND_SSD) {
            bf16* XC = (bf16*)(scr + SC_XC); float* DTR = (float*)(scr + SC_DTR); float* DT = (float*)(scr + SC_DT); float* ST = (float*)(scr + SC_ST); bf16* PV = (bf16*)(scr + SC_PV); float* CD = (float*)(scr + SC_CD);
            if (IN(base + 2)) REP(5) { FRESH(); ssd_conv_dt(c, BIG, INP(6) + (size_t)mj * S_CONVD * 4, INP(7) + (size_t)mj * S_CONVD, DTR, INP(8) + mj * 64, XC, DT); SEAM(); }
            if (IN(base + 3)) REP(6) { FRESH(); ssd_states(c, lds, XC, DT, INP(9) + mj * 64, ST, CD); SEAM(); }
            if (IN(base + 4)) REP(7) { FRESH(); ssd_chunk_scan(c, ST, CD, PV); SEAM(); }
            if (IN(base + 5)) REP(8) { FRESH(); ssd_out(c, lds, XC, BIG, DT, INP(9) + mj * 64, INP(10) + mj * 64, PV, INP(11) + (size_t)mj * S_DI, MIX); SEAM(); }
        } else if (kind == KIND_GLA) {
            float* GL = (float*)(scr + SC_GL); float* BC = (float*)(scr + SC_BC); float* KV = (float*)(scr + SC_KV); bf16* SP = (bf16*)(scr + SC_SP);
            if (IN(base + 2)) REP(9) { FRESH(); gla_bcum(c, GL, INP(14), INP(15), BC); SEAM(); }
            if (IN(base + 3)) REP(10) { FRESH(); gla_states(c, lds, BIG, BC, KV); SEAM(); }
            if (IN(base + 4)) REP(11) { FRESH(); gla_chunk_scan(c, KV, BC, SP); SEAM(); }
            if (IN(base + 5)) REP(12) { FRESH(); gla_out(c, lds, BIG, BC, SP, INP(16), MIX); SEAM(); }
        } else if (kind == KIND_SGU) {
            float* RS = (float*)(scr + SC_RS);
            if (IN(base + 2)) REP(13) { FRESH(); sgu_rstd(c, BIG, RS); SEAM(); }
            if (IN(base + 3)) REP(14) { FRESH(); sgu_mix(c, lds, BIG, RS, INP(21), INP(22), INP(20), MIX); SEAM(); }
        }
        if (IN(base + 6)) REP(4) {
            const bf16* A = kind == KIND_FFN ? BIG : MIX;
            const bf16* W = (const bf16*)(ws + (kind == KIND_FFN ? WS_W_FFN_OUT + fi * SZ_FFN_OUT : kind == KIND_SSD ? WS_W_SSD_OUT + mj * SZ_SSD_OUT : kind == KIND_GLA ? WS_W_GLA_OUT : WS_W_SGU_OUT));
            const int K = kind == KIND_FFN ? DFF : kind == KIND_GLA ? G_DV : 4096;
            pg8::Gemm g{A, W, SEQ, DM, K}; pg8::StaticOrder S; S.init(SEQ, DM, c0.G, (int)blockIdx.x);
            pg8::EpiResid E{H, DM, rep_ ? 0.f : (kind == KIND_FFN ? 0.5f : 1.0f)};
            pg8::gemm_phase<pg8::EpiResid, pg8::StaticOrder, true, true>(lds + RING_OFF, g, S, E);
            SEAM();
        }
    }
    if (IN(PH_FINAL)) { FRESH(); rmsnorm_rows<false>(c, H, INP(24), args.out); }
#undef IN
#undef SEAM
#undef FRESH
#undef INP
#undef REP
}

extern "C" void kernel_launch(void* const* d_in, const int* in_sizes, int n_in, void* d_out, int out_size, void* d_ws, size_t ws_size, hipStream_t stream) {
    static int grid = 0;
    if (grid == 0) {
        if (n_in != 25 || out_size != SEQ * DM || ws_size < WS_END) { fprintf(stderr, "kernel_launch: unexpected problem (n_in %d, out %d, ws %zu < %zu)\n", n_in, out_size, ws_size, (size_t)WS_END); grid = -1; return; }
        int dev = 0, cus = 0, per_cu = 0;
        if (hipGetDevice(&dev) != hipSuccess || hipDeviceGetAttribute(&cus, hipDeviceAttributeMultiprocessorCount, dev) != hipSuccess) { grid = -1; return; }
        if (hipFuncSetAttribute((const void*)mk_fwd, hipFuncAttributeMaxDynamicSharedMemorySize, LDS_BYTES) != hipSuccess) { fprintf(stderr, "kernel_launch: hipFuncSetAttribute failed\n"); grid = -1; return; }
        if (hipOccupancyMaxActiveBlocksPerMultiprocessor(&per_cu, (const void*)mk_fwd, NWAVES * 64, LDS_BYTES) != hipSuccess || per_cu < 1) fprintf(stderr, "kernel_launch: occupancy query reports %d\n", per_cu);
        (void)hipGetLastError();
        grid = cus;
    }
    if (grid < 0) return;
    if (hipMemsetAsync((char*)d_ws + WS_CTL, 0, CTL_ZERO_BYTES, stream) != hipSuccess) return;
    Args a{};
    for (int i = 0; i < 25; ++i) a.in[i] = (const float*)d_in[i];
    a.out = (float*)d_out; a.ws = (unsigned char*)d_ws;
#if MK_PER_PHASE
    for (int k = 0; k < NPH; ++k) { if (!slot_used(k)) continue; a.ph_lo = k; a.ph_hi = k + 1;
        hipLaunchKernelGGL(mk_fwd, dim3(grid), dim3(NWAVES * 64), LDS_BYTES, stream, a); }
#else
    a.ph_lo = 0; a.ph_hi = NPH;
    hipLaunchKernelGGL(mk_fwd, dim3(grid), dim3(NWAVES * 64), LDS_BYTES, stream, a);
#endif
    const hipError_t le = hipPeekAtLastError();
    if (le != hipSuccess) fprintf(stderr, "kernel_launch: launch failed: %s\n", hipGetErrorName(le));
}
```

```cpp
#include <hip/hip_runtime.h>
#include <cstdio>
#include <cstdint>
#ifndef MK_PER_PHASE
#define MK_PER_PHASE 0
#endif
#ifndef PROBE_DUP
#define PROBE_DUP 0
#endif
#undef MK_PER_PHASE
#define MK_PER_PHASE 0
namespace pg8 {
#define PG8_LAS __attribute__((address_space(3)))
typedef unsigned short bf16_t;
typedef short bf16x8 __attribute__((ext_vector_type(8)));
typedef float f32x4 __attribute__((ext_vector_type(4)));
typedef unsigned u32x4 __attribute__((ext_vector_type(4)));
constexpr int BM = 256, BK = 64, HALF = 128, HTB = HALF * BK * 2  , STAGE_BYTES = 8 * HTB, NXCD = 8, WGM = 8;

__host__ __device__ __forceinline__ int lds_byte(int r, int c) { const int st = (r >> 4) * 2 + (c >> 5), rr = r & 15, cc = c & 31, ob = rr * 64 + cc * 2; return st * 1024 + (ob ^ (((ob >> 9) & 1) << 5)); }
__host__ __device__ __forceinline__ void stage_rc(int b, int& R, int& C) { const int st = b / 1024, sb = b % 1024, swz = sb ^ (((sb >> 9) & 1) << 5); R = (st >> 1) * 16 + swz / 64; C = (st & 1) * 32 + (swz % 64) / 2; }
__host__ __device__ __forceinline__ int perm32(int rho) { const int n = rho >> 4, i = rho & 15; return 8 * (i >> 2) + 4 * n + (i & 3); }

struct Unit { int pm, pn; };
struct Gemm { const bf16_t* A; const bf16_t* Bt; int M, N, K; };

struct StaticOrder {
    int nM, nN, nwg, G, c;
    __host__ __device__ void init(int M, int N, int G_, int c_) { nM = M / BM; nN = N / BM; nwg = nM * nN; G = G_; c = c_; }
    __host__ __device__ __forceinline__ bool next(int i, Unit& u) const {
        const long L = (long)i * G + c; if (L >= nwg) return false;
        int wgid = (int)L; { const int q = nwg / NXCD, r = nwg % NXCD, xcd = wgid % NXCD, off = wgid / NXCD; wgid = (xcd < r ? xcd * (q + 1) : r * (q + 1) + (xcd - r) * q) + off; }
        const int nig = WGM * nN, gid = wgid / nig, fm = gid * WGM, gsz = (nM - fm) < WGM ? (nM - fm) : WGM;
        u.pm = fm + ((wgid % nig) % gsz); u.pn = (wgid % nig) / gsz; return true;
    }
    __device__ __forceinline__ void a_ready(const Unit&) const {}
    __device__ __forceinline__ void done(const Unit&) const {}
};
__device__ __forceinline__ unsigned cvt_pk_bf16(float lo, float hi) { unsigned r; asm volatile("v_cvt_pk_bf16_f32 %0, %1, %2" : "=v"(r) : "v"(lo), "v"(hi)); return r; }
typedef float f32x2 __attribute__((ext_vector_type(2)));
__device__ __forceinline__ f32x2 gelu_pk(f32x2 v) {
    const f32x2 av = __builtin_elementwise_abs(v), d = av * 0.2316418882f + 1.0f;
    f32x2 t; t.x = __builtin_amdgcn_rcpf(d.x); t.y = __builtin_amdgcn_rcpf(d.y);
    f32x2 q = t * 0.5307027145f + (-0.7265760135f); q = q * t + 0.7107068705f; q = q * t + (-0.142248368f); q = q * t + 0.127414796f; q = q * t;
    const f32x2 s = (v * v) * (-0.72134752044f);
    f32x2 e; e.x = __builtin_amdgcn_exp2f(s.x); e.y = __builtin_amdgcn_exp2f(s.y);
    const f32x2 m = v * (q * e), r = v - m;
    f32x2 o; o.x = v.x < 0.f ? m.x : r.x; o.y = v.y < 0.f ? m.y : r.y; return o;
}
__device__ __forceinline__ float silu_f(float x) { return x / (1.0f + __expf(-x)); }
__device__ __forceinline__ u32x4 pack8(const f32x4 v0, const f32x4 v1) { u32x4 w; w.x = cvt_pk_bf16(v0[0], v0[1]); w.y = cvt_pk_bf16(v0[2], v0[3]); w.z = cvt_pk_bf16(v1[0], v1[1]); w.w = cvt_pk_bf16(v1[2], v1[3]); return w; }

struct RowScale {
    const PG8_LAS float* RSL;
    __device__ __forceinline__ void get(float (&rs)[2][4], const Unit& u, int wr, int fr, int fq) const {
        const PG8_LAS float* t = RSL + (u.pm >> 3) * 256 + wr * 64 + fr;
#pragma unroll
        for (int ai = 0; ai < 2; ++ai)
#pragma unroll
            for (int m = 0; m < 4; ++m) rs[ai][m] = t[ai * HALF + m * 16];
    }
};
__device__ __forceinline__ void row_scale_table(PG8_LAS float* RSL, const float* PS, int r0) {
    int tid_ = threadIdx.x; asm volatile("" : "+v"(tid_));
#pragma unroll
    for (int k = 0; k < 2; ++k) { const int idx = tid_ + 512 * k, gid = idx >> 8;
        const f32x4* p = (const f32x4*)(PS + (size_t)((8 * gid + r0) * BM + (idx & 255)) * 32); float s = 0.f;
#pragma unroll
        for (int j = 0; j < 8; ++j) { const f32x4 v = p[j]; s += (v[0] + v[1]) + (v[2] + v[3]); }
        RSL[idx] = rsqrtf(s * (1.0f / 2048.0f) + 1e-6f); }
    __syncthreads();
}
struct EpiSwiGLU {
    static constexpr bool PERM = true, AFTER_DRAIN = false;
    bf16_t* O; int ldc; RowScale R;
    __device__ __forceinline__ void operator()(const f32x4 (&acc)[2][2][4][2], const Unit& u, int wr, int wc, int fr, int fq) const {
        const int row0 = u.pm * BM + wr * 64 + fr, col0 = u.pn * HALF + wc * 32 + 8 * fq;
        float rs[2][4]; R.get(rs, u, wr, fr, fq);
#pragma unroll
        for (int ai = 0; ai < 2; ++ai)
#pragma unroll
            for (int m = 0; m < 4; ++m) { bf16_t* rowp = O + (size_t)(row0 + ai * HALF + m * 16) * ldc + col0; const float s = rs[ai][m];
                f32x4 o0, o1;
#pragma unroll
                for (int i = 0; i < 4; ++i) { o0[i] = silu_f(acc[ai][0][m][0][i] * s) * (acc[ai][1][m][0][i] * s); o1[i] = silu_f(acc[ai][0][m][1][i] * s) * (acc[ai][1][m][1][i] * s); }
                *(u32x4*)rowp = pack8(o0, o1); }
    }
};
struct EpiResid {
    static constexpr bool PERM = true, AFTER_DRAIN = false;
    float* H; int ldc; float scale; const float* gain; bf16_t* HB; float* PS;
    __device__ __forceinline__ void operator()(const f32x4 (&acc)[2][2][4][2], const Unit& u, int wr, int wc, int fr, int fq) const {
        const int row0 = u.pm * BM + wr * 64 + fr, col0 = u.pn * BM + wc * 32 + 8 * fq;
        f32x4 gv[2][2];
#pragma unroll
        for (int bj = 0; bj < 2; ++bj)
#pragma unroll
            for (int n = 0; n < 2; ++n) gv[bj][n] = *(const f32x4*)(gain + col0 + bj * HALF + 4 * n);
#pragma unroll
        for (int ai = 0; ai < 2; ++ai)
#pragma unroll
            for (int m = 0; m < 4; ++m) { const int row = row0 + ai * HALF + m * 16; float* rowp = H + (size_t)row * ldc + col0; bf16_t* hbp = HB + (size_t)row * ldc + col0; float ssq = 0.f;
#pragma unroll
                for (int bj = 0; bj < 2; ++bj) { f32x4* p = (f32x4*)(rowp + bj * HALF);
                    const f32x4 h0 = p[0] + acc[ai][bj][m][0] * scale, h1 = p[1] + acc[ai][bj][m][1] * scale; p[0] = h0; p[1] = h1;
                    ssq += ((h0[0] * h0[0] + h0[1] * h0[1]) + (h0[2] * h0[2] + h0[3] * h0[3])) + ((h1[0] * h1[0] + h1[1] * h1[1]) + (h1[2] * h1[2] + h1[3] * h1[3]));
                    *(u32x4*)(hbp + bj * HALF) = pack8(h0 * gv[bj][0], h1 * gv[bj][1]); }
                ssq += __shfl_xor(ssq, 16); ssq += __shfl_xor(ssq, 32);
                if (fq == 0) PS[(size_t)row * 32 + u.pn * 4 + wc] = ssq; }
    }
};
struct EpiBf16X {
    static constexpr bool PERM = true, AFTER_DRAIN = false;
    bf16_t* O; int ldc; const float* bias; int npn_main; float* X; int nx; RowScale R;
    __device__ __forceinline__ void operator()(const f32x4 (&acc)[2][2][4][2], const Unit& u, int wr, int wc, int fr, int fq) const {
        const int row0 = u.pm * BM + wr * 64 + fr;
        float rs[2][4]; R.get(rs, u, wr, fr, fq);
        if (u.pn < npn_main) {
            const int col0 = u.pn * BM + wc * 32 + 8 * fq;
            f32x4 bv[2][2];
#pragma unroll
            for (int bj = 0; bj < 2; ++bj)
#pragma unroll
                for (int n = 0; n < 2; ++n) bv[bj][n] = bias ? *(const f32x4*)(bias + col0 + bj * HALF + 4 * n) : (f32x4){0.f, 0.f, 0.f, 0.f};
#pragma unroll
            for (int ai = 0; ai < 2; ++ai)
#pragma unroll
                for (int m = 0; m < 4; ++m) { bf16_t* rowp = O + (size_t)(row0 + ai * HALF + m * 16) * ldc + col0;
#pragma unroll
                    for (int bj = 0; bj < 2; ++bj) { f32x4 v0 = acc[ai][bj][m][0] * rs[ai][m] + bv[bj][0], v1 = acc[ai][bj][m][1] * rs[ai][m] + bv[bj][1];
                        if (bias) { f32x2 a = gelu_pk((f32x2){v0[0], v0[1]}), b = gelu_pk((f32x2){v0[2], v0[3]}), c = gelu_pk((f32x2){v1[0], v1[1]}), d = gelu_pk((f32x2){v1[2], v1[3]});
                            v0 = (f32x4){a.x, a.y, b.x, b.y}; v1 = (f32x4){c.x, c.y, d.x, d.y}; }
                        *(u32x4*)(rowp + bj * HALF) = pack8(v0, v1); } }
        } else {
            const int c0 = wc * 32 + 8 * fq;
            if (c0 < nx) {
#pragma unroll
                for (int ai = 0; ai < 2; ++ai)
#pragma unroll
                    for (int m = 0; m < 4; ++m) { float* rowp = X + (size_t)(row0 + ai * HALF + m * 16) * nx + c0;
                        *(f32x4*)rowp = acc[ai][0][m][0] * rs[ai][m]; *(f32x4*)(rowp + 4) = acc[ai][0][m][1] * rs[ai][m]; }
            }
        }
    }
};
template <class Epi, class Sched, bool ALIGN_EPI = false, bool SP2 = false>
__device__ __forceinline__ void gemm_phase(PG8_LAS unsigned char* lds, const Gemm g, const Sched& S, const Epi& E) {
    int tid_ = threadIdx.x; asm volatile("" : "+v"(tid_));
    const int tid = tid_, wid = __builtin_amdgcn_readfirstlane(tid >> 6), lane = tid & 63, wr = wid >> 2, wc = wid & 3, fr = lane & 15, fq = lane >> 4;
    const int K = g.K, nt = K / BK;
    unsigned voffA[2], voffB[2];
#pragma unroll
    for (int i = 0; i < 2; ++i) { int R, C; stage_rc(tid * 16 + i * 8192, R, C); const int Rb = Epi::PERM ? ((R & ~31) + perm32(R & 31)) : R;
        voffA[i] = (unsigned)(R * K + C) * 2u; voffB[i] = (unsigned)(Rb * K + C) * 2u; }
    const size_t kstep = (size_t)(BK * 2);
    const size_t hstep = (size_t)HALF * K * 2;
    const size_t tstep = 2 * hstep;
    const unsigned ldsw = (unsigned)wid * 1024u;
    const int aoff = lds_byte(wr * 64 + fr, fq * 8), boff = lds_byte(wc * 32 + fr, fq * 8);
#define PG8_SA(b, h) (((b) * 2 + (h)) * HTB)
#define PG8_SB(b, h) ((4 + (b) * 2 + (h)) * HTB)
#define PG8_STAGE(bufoff, gbase, voff) do { _Pragma("unroll") for (int _i = 0; _i < 2; ++_i) \
        __builtin_amdgcn_global_load_lds((const unsigned*)((const char*)(gbase) + (voff)[_i]), (PG8_LAS unsigned*)(lds + (bufoff) + ldsw + _i * 8192), 16, 0, 0); } while (0)
#define PG8_LDA(dst, b, h) do { _Pragma("unroll") for (int m = 0; m < 4; ++m) _Pragma("unroll") for (int k = 0; k < 2; ++k) dst[m][k] = *(const PG8_LAS bf16x8*)(lds + PG8_SA(b, h) + aoff + m * 2048 + k * 1024); } while (0)
#define PG8_LDB(dst, b, h) do { _Pragma("unroll") for (int n = 0; n < 2; ++n) _Pragma("unroll") for (int k = 0; k < 2; ++k) dst[n][k] = *(const PG8_LAS bf16x8*)(lds + PG8_SB(b, h) + boff + n * 2048 + k * 1024); } while (0)
#define PG8_MMA(ai, bj, At, Bt) do { __builtin_amdgcn_s_setprio(1); _Pragma("unroll") for (int m = 0; m < 4; ++m) _Pragma("unroll") for (int n = 0; n < 2; ++n) _Pragma("unroll") for (int k = 0; k < 2; ++k) \
        acc[ai][bj][m][n] = __builtin_amdgcn_mfma_f32_16x16x32_bf16(Bt[n][k], At[m][k], acc[ai][bj][m][n], 0, 0, 0); __builtin_amdgcn_s_setprio(0); } while (0)
#define PG8_WAIT_V(n) asm volatile("s_waitcnt vmcnt(" #n ")" ::: "memory")
#define PG8_WAIT_L(n) asm volatile("s_waitcnt lgkmcnt(" #n ")" ::: "memory")
#define PG8_BAR __builtin_amdgcn_s_barrier()
#define PG8_SCHED __builtin_amdgcn_sched_barrier(0)
    Unit cur, nxt; int ui = 0;
    if (!S.next(0, cur)) return;
    f32x4 acc[2][2][4][2];
#pragma unroll
    for (int a = 0; a < 2; ++a)
#pragma unroll
        for (int b = 0; b < 2; ++b)
#pragma unroll
            for (int m = 0; m < 4; ++m)
#pragma unroll
                for (int n = 0; n < 2; ++n) acc[a][b][m][n] = (f32x4){0.f, 0.f, 0.f, 0.f};
    bf16x8 At[4][2], B0[2][2], B1[2][2];
    const char* cA = (const char*)g.A + (size_t)cur.pm * tstep; const char* cB = (const char*)g.Bt + (size_t)cur.pn * tstep;
    S.a_ready(cur);
    if constexpr (SP2) {
        PG8_STAGE(PG8_SB(0, 0), cB, voffB); PG8_STAGE(PG8_SB(0, 1), cB + hstep, voffB); PG8_STAGE(PG8_SA(0, 0), cA, voffA); PG8_STAGE(PG8_SA(0, 1), cA + hstep, voffA);
        if (wr == 1) PG8_BAR;
        PG8_WAIT_V(2); PG8_BAR;
        PG8_STAGE(PG8_SB(1, 0), cB + kstep, voffB); PG8_STAGE(PG8_SA(1, 0), cA + kstep, voffA); PG8_STAGE(PG8_SB(1, 1), cB + hstep + kstep, voffB);
        PG8_WAIT_V(6); PG8_BAR;
    } else {
        PG8_STAGE(PG8_SB(0, 0), cB, voffB); PG8_STAGE(PG8_SA(0, 0), cA, voffA); PG8_STAGE(PG8_SB(0, 1), cB + hstep, voffB); PG8_STAGE(PG8_SA(0, 1), cA + hstep, voffA);
        if (wr == 1) PG8_BAR;
        PG8_WAIT_V(4); PG8_BAR;
        PG8_STAGE(PG8_SB(1, 0), cB + kstep, voffB); PG8_STAGE(PG8_SA(1, 0), cA + kstep, voffA); PG8_STAGE(PG8_SB(1, 1), cB + hstep + kstep, voffB);
        PG8_WAIT_V(6); PG8_BAR;
    }
    for (;;) {
        const bool has_next = S.next(ui + 1, nxt);
        const char* nA = has_next ? (const char*)g.A + (size_t)nxt.pm * tstep : cA; const char* nB = has_next ? (const char*)g.Bt + (size_t)nxt.pn * tstep : cB;
        for (int t = 0; t < nt; t += 2) {
            const bool last = (t == nt - 2);
            const char* a1 = cA + (size_t)(t + 1) * kstep;
            const char* a2 = last ? nA : cA + (size_t)(t + 2) * kstep; const char* b2 = last ? nB : cB + (size_t)(t + 2) * kstep;
            const char* a3 = a2 + kstep; const char* b3 = b2 + kstep;
            if (last && has_next) S.a_ready(nxt);
            if constexpr (SP2) {
            PG8_LDB(B0, 0, 0); PG8_LDB(B1, 0, 1); PG8_SCHED; PG8_LDA(At, 0, 0); PG8_STAGE(PG8_SA(1, 1), a1 + hstep, voffA);
            PG8_WAIT_V(8); PG8_WAIT_L(0); PG8_BAR; PG8_MMA(0, 0, At, B0); PG8_MMA(0, 1, At, B1); PG8_BAR; PG8_SCHED;
            PG8_LDA(At, 0, 1); PG8_STAGE(PG8_SB(0, 0), b2, voffB); PG8_STAGE(PG8_SB(0, 1), b2 + hstep, voffB); PG8_STAGE(PG8_SA(0, 0), a2, voffA);
            PG8_WAIT_V(8); PG8_WAIT_L(0); PG8_BAR; PG8_MMA(1, 0, At, B0); PG8_MMA(1, 1, At, B1); PG8_BAR; PG8_SCHED;
            PG8_LDB(B0, 1, 0); PG8_LDB(B1, 1, 1); PG8_SCHED; PG8_LDA(At, 1, 0); PG8_STAGE(PG8_SA(0, 1), a2 + hstep, voffA);
            PG8_WAIT_V(8); PG8_WAIT_L(0); PG8_BAR; PG8_MMA(0, 0, At, B0); PG8_MMA(0, 1, At, B1); PG8_BAR; PG8_SCHED;
            PG8_LDA(At, 1, 1); PG8_STAGE(PG8_SB(1, 0), b3, voffB); PG8_STAGE(PG8_SB(1, 1), b3 + hstep, voffB); PG8_STAGE(PG8_SA(1, 0), a3, voffA);
            PG8_WAIT_V(8); PG8_WAIT_L(0); PG8_BAR; PG8_MMA(1, 0, At, B0); PG8_MMA(1, 1, At, B1); PG8_BAR; PG8_SCHED;
            } else {
            PG8_LDB(B0, 0, 0); PG8_SCHED; PG8_LDA(At, 0, 0); PG8_STAGE(PG8_SA(1, 1), a1 + hstep, voffA);
            PG8_WAIT_L(8); PG8_BAR; PG8_WAIT_L(0); PG8_MMA(0, 0, At, B0); PG8_BAR; PG8_SCHED;
            PG8_LDB(B1, 0, 1); PG8_STAGE(PG8_SB(0, 0), b2, voffB);
            PG8_BAR; PG8_WAIT_L(0); PG8_MMA(0, 1, At, B1); PG8_BAR;
            PG8_LDA(At, 0, 1); PG8_STAGE(PG8_SA(0, 0), a2, voffA);
            PG8_BAR; PG8_WAIT_L(0); PG8_MMA(1, 0, At, B0); PG8_BAR; PG8_SCHED;
            PG8_STAGE(PG8_SB(0, 1), b2 + hstep, voffB);
            PG8_WAIT_V(6); PG8_BAR; PG8_MMA(1, 1, At, B1); PG8_BAR;
            PG8_LDB(B0, 1, 0); PG8_SCHED; PG8_LDA(At, 1, 0); PG8_STAGE(PG8_SA(0, 1), a2 + hstep, voffA);
            PG8_WAIT_L(8); PG8_BAR; PG8_WAIT_L(0); PG8_MMA(0, 0, At, B0); PG8_BAR; PG8_SCHED;
            PG8_LDB(B1, 1, 1); PG8_STAGE(PG8_SB(1, 0), b3, voffB);
            PG8_BAR; PG8_WAIT_L(0); PG8_MMA(0, 1, At, B1); PG8_BAR;
            PG8_LDA(At, 1, 1); PG8_STAGE(PG8_SA(1, 0), a3, voffA);
            PG8_BAR; PG8_WAIT_L(0); PG8_MMA(1, 0, At, B0); PG8_BAR; PG8_SCHED;
            PG8_STAGE(PG8_SB(1, 1), b3 + hstep, voffB);
            PG8_WAIT_V(6); PG8_BAR; PG8_MMA(1, 1, At, B1); PG8_BAR;
            }
        }
        if constexpr (ALIGN_EPI) { if (wr == 0) PG8_BAR; }
        if constexpr (!Epi::AFTER_DRAIN) { E(acc, cur, wr, wc, fr, fq); S.done(cur); }
        if (!has_next) break;
#pragma unroll
        for (int a = 0; a < 2; ++a)
#pragma unroll
            for (int b = 0; b < 2; ++b)
#pragma unroll
                for (int m = 0; m < 4; ++m)
#pragma unroll
                    for (int n = 0; n < 2; ++n) acc[a][b][m][n] = (f32x4){0.f, 0.f, 0.f, 0.f};
        cur = nxt; cA = nA; cB = nB; ++ui;
        if constexpr (ALIGN_EPI) { if (wr == 1) PG8_BAR; }
    }
    PG8_WAIT_V(0);
    if constexpr (!ALIGN_EPI) { if (wr == 0) PG8_BAR; }
    PG8_BAR;
    if constexpr (Epi::AFTER_DRAIN) { E.fused(acc, cur, wr, wc, fr, fq, lds, wid, lane); S.done(cur); }
#undef PG8_SA
#undef PG8_SB
#undef PG8_STAGE
#undef PG8_LDA
#undef PG8_LDB
#undef PG8_MMA
#undef PG8_WAIT_V
#undef PG8_WAIT_L
#undef PG8_BAR
#undef PG8_SCHED
}
}
constexpr int SEQ = 8192, DM = 2048, DFF = 5632, DEPTH = 4, NWAVES = 8;
constexpr float EPS = 1e-6f;
constexpr int S_DI = 4096, S_NH = 64, S_P = 64, S_G = 8, S_N = 128, S_CONVD = 6144, S_IN = 10304, S_INP = 10496, S_ZX = 10240;
constexpr int G_H = 4, G_DK = 1024, G_DV = 2048, G_HK = 256, G_HV = 512, G_R = 16, G_IN = 6160, G_INP = 6400, G_QKVR = 6144;
constexpr int U_W = 4096, U_G = 8, U_GD = 512, U_Q = 128;

constexpr size_t MiB = 1u << 20;
constexpr size_t WS_CTL = 0, CTL_ZERO_BYTES = 1 * MiB;
constexpr size_t SZ_FFN_IN = (size_t)2 * DFF * DM * 2, SZ_FFN_OUT = (size_t)DM * DFF * 2;
constexpr size_t SZ_SSD_IN = (size_t)S_INP * DM * 2, SZ_SSD_OUT = (size_t)DM * S_DI * 2;
constexpr size_t WS_W_FFN_IN = 1 * MiB;
constexpr size_t WS_W_FFN_OUT = WS_W_FFN_IN + 8 * SZ_FFN_IN;
constexpr size_t WS_W_SSD_IN = WS_W_FFN_OUT + 8 * SZ_FFN_OUT;
constexpr size_t WS_W_SSD_OUT = WS_W_SSD_IN + 2 * SZ_SSD_IN;
constexpr size_t WS_W_GLA_IN = WS_W_SSD_OUT + 2 * SZ_SSD_OUT;
constexpr size_t WS_W_GLA_OUT = WS_W_GLA_IN + (size_t)G_INP * DM * 2;
constexpr size_t WS_W_SGU_IN = WS_W_GLA_OUT + (size_t)DM * G_DV * 2;
constexpr size_t WS_W_SGU_OUT = WS_W_SGU_IN + (size_t)2 * U_W * DM * 2;
constexpr size_t WS_W_END = WS_W_SGU_OUT + (size_t)DM * U_W * 2;
constexpr size_t WS_H = (WS_W_END + MiB - 1) / MiB * MiB;
constexpr size_t WS_HN = WS_H + (size_t)SEQ * DM * 4;
constexpr size_t WS_BIG = WS_HN + (size_t)SEQ * DM * 2;
constexpr size_t WS_MIX = WS_BIG + (size_t)SEQ * S_ZX * 2;
constexpr size_t WS_SCR = WS_MIX + (size_t)SEQ * 4096 * 2;
constexpr size_t WS_SCR_BYTES = 512 * MiB;
constexpr size_t WS_PS = WS_SCR + WS_SCR_BYTES;
constexpr size_t WS_END = WS_PS + (size_t)SEQ * 32 * 4;
static_assert(WS_H % 256 == 0 && WS_W_SSD_IN % 256 == 0 && WS_W_GLA_IN % 256 == 0, "alignment");
constexpr size_t SC_XC = 0;
constexpr size_t SC_DTR = SC_XC + (size_t)SEQ * S_CONVD * 2;
constexpr size_t SC_DT = SC_DTR + (size_t)SEQ * 64 * 4;
constexpr size_t SC_ST = SC_DT + (size_t)SEQ * 64 * 4;
constexpr size_t SC_PV = SC_ST + (size_t)64 * 64 * 64 * 128 * 4;
constexpr size_t SC_CD = SC_PV + (size_t)64 * 64 * 64 * 128 * 2;
constexpr size_t SC_SSD_END = SC_CD + 64 * 64 * 4;
constexpr size_t SC_GL = 0;
constexpr size_t SC_BC = SC_GL + (size_t)SEQ * 16 * 4;
constexpr size_t SC_KV = SC_BC + (size_t)SEQ * 1024 * 4;
constexpr size_t SC_SP = SC_KV + (size_t)128 * 4 * 512 * 256 * 4;
constexpr size_t SC_GLA_END = SC_SP + (size_t)128 * 4 * 512 * 256 * 2;
constexpr size_t SC_RS = 0;
static_assert(SC_SSD_END <= WS_SCR_BYTES && SC_GLA_END <= WS_SCR_BYTES, "scratch map");
constexpr int CW_BAR = 4096;

constexpr int RING_OFF = 0, RING_BYTES = 131072;
constexpr int LDS_BYTES = 163840;
constexpr int LDSCTL_OFF = LDS_BYTES - 1024, MISC_OFF = LDSCTL_OFF + 320;

#define GAS __attribute__((address_space(1)))
#define LAS __attribute__((address_space(3)))
typedef unsigned short bf16;
typedef unsigned v4u __attribute__((ext_vector_type(4)));
typedef unsigned v2u __attribute__((ext_vector_type(2)));
typedef float f32x4 __attribute__((ext_vector_type(4)));
#define LDS_WAIT() asm volatile("s_waitcnt lgkmcnt(0)" ::: "memory")
__device__ __forceinline__ unsigned f2bf(float f) { unsigned u = __builtin_bit_cast(unsigned, f); return (u + 0x7fffu + ((u >> 16) & 1u)) >> 16; }
__device__ __forceinline__ unsigned pk2(float lo, float hi) { return f2bf(lo) | (f2bf(hi) << 16); }
__device__ __forceinline__ float bf_lo(unsigned w) { return __builtin_bit_cast(float, w << 16); }
__device__ __forceinline__ float bf_hi(unsigned w) { return __builtin_bit_cast(float, w & 0xffff0000u); }
__device__ __forceinline__ float bf2f(bf16 b) { return __builtin_bit_cast(float, (unsigned)b << 16); }
__device__ __forceinline__ float silu(float x) { return x / (1.0f + __expf(-x)); }
__device__ __forceinline__ float softplus(float x) { return x > 20.f ? x : log1pf(__expf(x)); }
__device__ __forceinline__ float wave_sum(float v) {
#pragma unroll
    for (int o = 1; o < 64; o <<= 1) v += __shfl_xor(v, o);
    return v;
}
#define XB_TMO      128
#define XB_XCNT(j)  (256  + 64 * (j))
#define XB_XSUB(j)  (1280 + 64 * (j))
#define XB_XGEN(j)  (2304 + 64 * (j))
#define XB_TOP      3328
#define XB_TOPGEN   3392
#define XCD_BAR_WORDS 3456
#define XB_SPIN_CAP (1u << 18)

__device__ __forceinline__ unsigned xb_ld(unsigned* p)              { return __hip_atomic_load(p, __ATOMIC_RELAXED, __HIP_MEMORY_SCOPE_AGENT); }
__device__ __forceinline__ unsigned xb_add(unsigned* p, unsigned v) { return __hip_atomic_fetch_add(p, v, __ATOMIC_RELAXED, __HIP_MEMORY_SCOPE_AGENT); }
__device__ __forceinline__ unsigned xb_xcc_id() { return (unsigned)__builtin_amdgcn_s_getreg((3 << 11) | 20) & 0xFu; }
#define XB_SPIN(cond, bar) do { unsigned _sp = 0; while (cond) { __builtin_amdgcn_s_sleep(1); \
    if ((++_sp & 255u) == 0u) { if (xb_ld(&(bar)[XB_TMO])) break; if (_sp > XB_SPIN_CAP) { atomicAdd(&(bar)[XB_TMO], 1u); break; } } } } while (0)

struct XcdBarrier {
    unsigned* bar; unsigned x;
    volatile LAS unsigned* st;
};

__device__ __forceinline__ XcdBarrier xcd_barrier_post(unsigned* bar, volatile LAS unsigned* st) {
    XcdBarrier b; b.bar = bar; b.x = xb_xcc_id(); b.st = st;
    if (threadIdx.x == 0) (void)xb_add(&bar[XB_XCNT(b.x)], 1u);
    return b;
}
__device__ __forceinline__ void xcd_barrier_complete(unsigned* bar, unsigned x, unsigned& nloc, unsigned& nx) {
    const unsigned G = gridDim.x * gridDim.y * gridDim.z;
    unsigned sum, cnt, mine, sp = 0u;
    for (;;) {
        sum = 0u; cnt = 0u; mine = 0u;
#pragma unroll
        for (unsigned j = 0; j < 16; ++j) { const unsigned c = xb_ld(&bar[XB_XCNT(j)]); sum += c; cnt += (c > 0u) ? 1u : 0u; mine = (j == x) ? c : mine; }
        if (sum == G) break;
        __builtin_amdgcn_s_sleep(1);
        if ((++sp & 255u) == 0u) { if (xb_ld(&bar[XB_TMO])) break; if (sp > XB_SPIN_CAP) { atomicAdd(&bar[XB_TMO], 1u); break; } }
    }
    nloc = mine > 0u ? mine : 1u; nx = cnt > 0u ? cnt : 1u;
}

__device__ __forceinline__ void xcd_barrier(const XcdBarrier& b) {
    asm volatile("s_waitcnt vmcnt(0)" ::: "memory");
    __syncthreads();
    if (threadIdx.x == 0) {
        unsigned* bar = b.bar;
        __builtin_amdgcn_s_waitcnt(0);
        unsigned nloc = b.st[0], nx = b.st[1];
        if (nloc == 0u) { xcd_barrier_complete(bar, b.x, nloc, nx); b.st[0] = nloc; b.st[1] = nx; }
        const unsigned old = xb_add(&bar[XB_XSUB(b.x)], 1u);
        const unsigned gen = old / nloc;
        if (old + 1u == (gen + 1u) * nloc) {
            __builtin_amdgcn_fence(__ATOMIC_RELEASE, "agent");
            asm volatile("s_waitcnt vmcnt(0)" ::: "memory");
            const unsigned og = xb_add(&bar[XB_TOP], 1u);
            const unsigned tg = og / nx;
            if (og + 1u == (tg + 1u) * nx) xb_add(&bar[XB_TOPGEN], 1u);
            else XB_SPIN(xb_ld(&bar[XB_TOPGEN]) == tg, bar);
            __builtin_amdgcn_fence(__ATOMIC_ACQUIRE, "agent");
            xb_add(&bar[XB_XGEN(b.x)], 1u);
            asm volatile("s_waitcnt vmcnt(0)" ::: "memory");
        } else {
            XB_SPIN(xb_ld(&bar[XB_XGEN(b.x)]) == gen, bar);
            __builtin_amdgcn_fence(__ATOMIC_ACQUIRE, "agent");
            asm volatile("s_waitcnt vmcnt(0)" ::: "memory");
        }
    }
    __syncthreads();
}

struct Ctx { int tid, lane, wave, G, vcu, gw, NGW, gtid, NT; };

__device__ __forceinline__ void tr_load(f32x4 (&v)[8], const float* W, int Nsrc, int n0, int k0, int lane) {
    const int n = n0 + 4 * (lane & 7); const bool ok = n < Nsrc; const float* p = W + (size_t)(k0 + 8 * (lane >> 3)) * Nsrc + n;
#pragma unroll
    for (int r = 0; r < 8; ++r) v[r] = ok ? *(const f32x4*)(p + (size_t)r * Nsrc) : (f32x4){0.f, 0.f, 0.f, 0.f};
}
__device__ __forceinline__ void tr_store(const f32x4 (&v)[8], bf16* WT, int K, int d0, int k0, int lane) {
    bf16* q = WT + (size_t)(d0 + 4 * (lane & 7)) * K + k0 + 8 * (lane >> 3);
#pragma unroll
    for (int j = 0; j < 4; ++j) { v4u o; o.x = pk2(v[0][j], v[1][j]); o.y = pk2(v[2][j], v[3][j]); o.z = pk2(v[4][j], v[5][j]); o.w = pk2(v[6][j], v[7][j]); *(v4u*)(q + (size_t)j * K) = o; }
}
template <int MODE> __device__ __forceinline__ int tr_src_col(int d0) { if (MODE == 1) { const int pn = d0 >> 8, bj = (d0 >> 7) & 1, j0 = d0 & 127; return bj * DFF + 128 * pn + j0; } return d0; }
template <int MODE> __device__ __forceinline__ void convert_matrix(const Ctx& c, const float* W, int K, int Nsrc, int Ndst, bf16* WT) {
    const int nblk = Ndst / 32, nitems = (K / 64) * nblk;
    constexpr int U = 4;
    for (int it0 = c.gw; it0 < nitems; it0 += U * c.NGW) {
        f32x4 v[U][8];
#pragma unroll
        for (int u = 0; u < U; ++u) { const int it = it0 + u * c.NGW; if (it < nitems) { const int kb = it / nblk, nb = it % nblk; tr_load(v[u], W, Nsrc, tr_src_col<MODE>(32 * nb), 64 * kb, c.lane); } }
#pragma unroll
        for (int u = 0; u < U; ++u) { const int it = it0 + u * c.NGW; if (it < nitems) { const int kb = it / nblk, nb = it % nblk; tr_store(v[u], WT, K, 32 * nb, 64 * kb, c.lane); } }
    }
}

template <bool OUT_BF16> __device__ __forceinline__ void rmsnorm_rows(const Ctx& c, const float* X, const float* gain, void* out) {
    for (int m = c.gw; m < SEQ; m += c.NGW) {
        const f32x4* xr = (const f32x4*)(X + (size_t)m * DM) + c.lane;
        f32x4 v[8]; float s = 0.f;
#pragma unroll
        for (int j = 0; j < 8; ++j) { v[j] = xr[64 * j]; s += (v[j].x * v[j].x + v[j].y * v[j].y) + (v[j].z * v[j].z + v[j].w * v[j].w); }
        const float rs = rsqrtf(wave_sum(s) * (1.f / DM) + EPS);
        const f32x4* gr = (const f32x4*)gain + c.lane;
#pragma unroll
        for (int j = 0; j < 8; ++j) { const f32x4 g = gr[64 * j]; const f32x4 o = v[j] * rs * g;
            if (OUT_BF16) { v2u w; w.x = pk2(o.x, o.y); w.y = pk2(o.z, o.w); *((v2u*)((bf16*)out + (size_t)m * DM) + c.lane + 64 * j) = w; }
            else *((f32x4*)((float*)out + (size_t)m * DM) + c.lane + 64 * j) = o; }
    }
}

__device__ __forceinline__ void init_rows(const Ctx& c, const float* X, const float* gain, float* H, bf16* HB, float* PS) {
    for (int m = c.gw; m < SEQ; m += c.NGW) {
        const f32x4* xr = (const f32x4*)(X + (size_t)m * DM) + c.lane; const f32x4* gr = (const f32x4*)gain + c.lane;
        float s = 0.f;
#pragma unroll
        for (int j = 0; j < 8; ++j) { const f32x4 v = xr[64 * j], g = gr[64 * j]; s += (v.x * v.x + v.y * v.y) + (v.z * v.z + v.w * v.w);
            *((f32x4*)(H + (size_t)m * DM) + c.lane + 64 * j) = v; const f32x4 o = v * g; v2u w; w.x = pk2(o.x, o.y); w.y = pk2(o.z, o.w); *((v2u*)(HB + (size_t)m * DM) + c.lane + 64 * j) = w; }
        s = wave_sum(s);
        if (c.lane < 32) PS[(size_t)m * 32 + c.lane] = (c.lane == 0) ? s : 0.f;
    }
}

__device__ __forceinline__ void ssd_conv_dt(const Ctx& c, const bf16* ZX, const float* cw, const float* cb, const float* DTR, const float* dtb, bf16* XC, float* DT) {
    constexpr int NV = S_CONVD / 8, RB = 8;
    for (int it = c.gtid; it < (SEQ / RB) * NV; it += c.NT) {
        const int tb = (it / NV) * RB, ch = (it % NV) * 8;
        f32x4 w[8]; float bias[8];
#pragma unroll
        for (int j = 0; j < 8; ++j) { w[j] = *(const f32x4*)(cw + (size_t)(ch + j) * 4); bias[j] = cb[ch + j]; }
        v4u x[RB + 3];
#pragma unroll
        for (int r = 0; r < RB + 3; ++r) { const int ts = tb - 3 + r; x[r] = (ts >= 0) ? *(const v4u*)(ZX + (size_t)ts * S_ZX + S_DI + ch) : (v4u){0u, 0u, 0u, 0u}; }
#pragma unroll
        for (int r = 0; r < RB; ++r) { float a[8];
#pragma unroll
            for (int j = 0; j < 8; ++j) a[j] = bias[j];
#pragma unroll
            for (int k = 0; k < 4; ++k) { const unsigned xw[4] = {x[r + k].x, x[r + k].y, x[r + k].z, x[r + k].w};
#pragma unroll
                for (int j = 0; j < 4; ++j) { a[2 * j] += bf_lo(xw[j]) * w[2 * j][k]; a[2 * j + 1] += bf_hi(xw[j]) * w[2 * j + 1][k]; } }
            v4u o; o.x = pk2(silu(a[0]), silu(a[1])); o.y = pk2(silu(a[2]), silu(a[3])); o.z = pk2(silu(a[4]), silu(a[5])); o.w = pk2(silu(a[6]), silu(a[7]));
            *(v4u*)(XC + (size_t)(tb + r) * S_CONVD + ch) = o; }
    }
    for (int it = c.gtid; it < SEQ * 64; it += c.NT) DT[it] = softplus(DTR[it] + dtb[it & 63]);
}
__device__ __forceinline__ void ssd_scan_naive(const Ctx& c, const bf16* XC, const bf16* ZX, const float* DT, const float* a_log, const float* dskip, float* YG) {
    for (int item = c.gw; item < S_NH * S_P; item += c.NGW) {
        const int h = item >> 6, p = item & 63, g = h >> 3;
        const float a = -__expf(a_log[h]), Dh = dskip[h];
        float s0 = 0.f, s1 = 0.f;
        const bf16* xcol = XC + h * 64 + p; const bf16* bcol = XC + S_DI + g * S_N + 2 * c.lane; const bf16* ccol = XC + S_DI + S_G * S_N + g * S_N + 2 * c.lane;
        const bf16* zcol = ZX + h * 64 + p; const float* dtp = DT + h;
        for (int t0 = 0; t0 < SEQ; t0 += 8) {
            float dtv[8], xv[8], zv[8]; unsigned bb[8], cc[8];
#pragma unroll
            for (int j = 0; j < 8; ++j) { const size_t t = t0 + j; dtv[j] = dtp[t * 64]; xv[j] = bf2f(xcol[t * S_CONVD]); zv[j] = bf2f(zcol[t * S_ZX]);
                bb[j] = *(const unsigned*)(bcol + t * S_CONVD); cc[j] = *(const unsigned*)(ccol + t * S_CONVD); }
#pragma unroll
            for (int j = 0; j < 8; ++j) { const float dA = __expf(dtv[j] * a), xd = dtv[j] * xv[j];
                s0 = s0 * dA + xd * bf_lo(bb[j]); s1 = s1 * dA + xd * bf_hi(bb[j]);
                const float y = wave_sum(bf_lo(cc[j]) * s0 + bf_hi(cc[j]) * s1) + Dh * xv[j];
                if (c.lane == 0) YG[(size_t)(t0 + j) * S_DI + h * 64 + p] = y * silu(zv[j]); }
        }
    }
}
__device__ __forceinline__ void ssd_groupnorm(const Ctx& c, const float* YG, const float* nw, bf16* MIX) {
    for (int it = c.gw; it < SEQ * S_G; it += c.NGW) {
        const size_t off = (size_t)it * 512 + 8 * c.lane; const int col = (it & 7) * 512 + 8 * c.lane;
        const f32x4 a = *(const f32x4*)(YG + off), b = *(const f32x4*)(YG + off + 4);
        const float ss = (a.x * a.x + a.y * a.y) + (a.z * a.z + a.w * a.w) + (b.x * b.x + b.y * b.y) + (b.z * b.z + b.w * b.w);
        const float rs = rsqrtf(wave_sum(ss) * (1.f / 512.f) + EPS);
        const f32x4 wa = *(const f32x4*)(nw + col), wb = *(const f32x4*)(nw + col + 4);
        v4u o; o.x = pk2(a.x * rs * wa.x, a.y * rs * wa.y); o.y = pk2(a.z * rs * wa.z, a.w * rs * wa.w); o.z = pk2(b.x * rs * wb.x, b.y * rs * wb.y); o.w = pk2(b.z * rs * wb.z, b.w * rs * wb.w);
        *(v4u*)(MIX + off) = o;
    }
}

__device__ __forceinline__ void gla_gate(const Ctx& c, const float* GL, const float* w2, const float* bg, float* AG) {
    for (int it = c.gtid; it < SEQ * G_DK; it += c.NT) {
        const int t = it >> 10, cc = it & 1023; float x = bg[cc];
#pragma unroll
        for (int r = 0; r < 16; ++r) x += GL[t * 16 + r] * w2[r * G_DK + cc];
        const float ls = -softplus(-x);
        AG[it] = __expf(ls * (1.f / 16.f));
    }
}
__device__ __forceinline__ void gla_scan_naive(const Ctx& c, const bf16* QKVR, const float* AG, float* OG) {
    for (int item = c.gw; item < G_H * G_HV; item += c.NGW) {
        const int h = item >> 9, v = item & 511;
        float S0 = 0.f, S1 = 0.f, S2 = 0.f, S3 = 0.f;
        const float* ap = AG + h * G_HK + 4 * c.lane; const bf16* qp = QKVR + h * G_HK + 4 * c.lane; const bf16* kp = QKVR + G_DK + h * G_HK + 4 * c.lane; const bf16* vp = QKVR + 2 * G_DK + h * G_HV + v;
        for (int t0 = 0; t0 < SEQ; t0 += 4) {
            f32x4 a4[4]; v2u k4[4], q4[4]; float vv[4];
#pragma unroll
            for (int j = 0; j < 4; ++j) { const size_t t = t0 + j; a4[j] = *(const f32x4*)(ap + t * G_DK); k4[j] = *(const v2u*)(kp + t * G_QKVR); q4[j] = *(const v2u*)(qp + t * G_QKVR); vv[j] = bf2f(vp[t * G_QKVR]); }
#pragma unroll
            for (int j = 0; j < 4; ++j) {
                S0 = S0 * a4[j].x + bf_lo(k4[j].x) * vv[j]; S1 = S1 * a4[j].y + bf_hi(k4[j].x) * vv[j]; S2 = S2 * a4[j].z + bf_lo(k4[j].y) * vv[j]; S3 = S3 * a4[j].w + bf_hi(k4[j].y) * vv[j];
                const float o = wave_sum((bf_lo(q4[j].x) * S0 + bf_hi(q4[j].x) * S1) + (bf_lo(q4[j].y) * S2 + bf_hi(q4[j].y) * S3)) * (1.f / 16.f);
                if (c.lane == 0) OG[(size_t)(t0 + j) * G_DV + h * G_HV + v] = o; }
        }
    }
}
__device__ __forceinline__ void gla_outnorm(const Ctx& c, const float* OG, const bf16* QKVR, const float* nw, bf16* MIX) {
    for (int it = c.gw; it < SEQ * G_H; it += c.NGW) {
        const int t = it >> 2, h = it & 3; const size_t off = (size_t)it * 512 + 8 * c.lane;
        const f32x4 a = *(const f32x4*)(OG + off), b = *(const f32x4*)(OG + off + 4);
        const float ss = (a.x * a.x + a.y * a.y) + (a.z * a.z + a.w * a.w) + (b.x * b.x + b.y * b.y) + (b.z * b.z + b.w * b.w);
        const float rs = rsqrtf(wave_sum(ss) * (1.f / 512.f) + EPS);
        const f32x4 wa = *(const f32x4*)(nw + 8 * c.lane), wb = *(const f32x4*)(nw + 8 * c.lane + 4);
        const v4u r = *(const v4u*)(QKVR + (size_t)t * G_QKVR + 2 * G_DK + G_DV + h * G_HV + 8 * c.lane);
        v4u o; o.x = pk2(a.x * rs * wa.x * silu(bf_lo(r.x)), a.y * rs * wa.y * silu(bf_hi(r.x))); o.y = pk2(a.z * rs * wa.z * silu(bf_lo(r.y)), a.w * rs * wa.w * silu(bf_hi(r.y)));
        o.z = pk2(b.x * rs * wb.x * silu(bf_lo(r.z)), b.y * rs * wb.y * silu(bf_hi(r.z))); o.w = pk2(b.z * rs * wb.z * silu(bf_lo(r.w)), b.w * rs * wb.w * silu(bf_hi(r.w)));
        *(v4u*)(MIX + off) = o;
    }
}

__device__ __forceinline__ void sgu_rstd(const Ctx& c, const bf16* ZZ, float* RS) {
    for (int t = c.gw; t < SEQ; t += c.NGW) {
        const v4u* p = (const v4u*)(ZZ + (size_t)t * 8192 + U_W) + c.lane; float s = 0.f;
#pragma unroll
        for (int j = 0; j < 8; ++j) { const v4u x = p[64 * j]; const unsigned w[4] = {x.x, x.y, x.z, x.w};
#pragma unroll
            for (int i = 0; i < 4; ++i) { const float lo = bf_lo(w[i]), hi = bf_hi(w[i]); s += lo * lo + hi * hi; } }
        s = wave_sum(s);
        if (c.lane == 0) RS[t] = rsqrtf(s * (1.f / U_W) + EPS);
    }
}
__device__ __forceinline__ void sgu_mix_naive(const Ctx& c, const bf16* ZZ, const float* RS, const float* WS, const float* BS, const float* nw, bf16* MIX) {
    for (int it = c.gw; it < SEQ * U_G; it += c.NGW) {
        const int g = it & 7, t = it >> 3, c0 = t & ~127, tt = t & 127;
        float acc[8];
#pragma unroll
        for (int j = 0; j < 8; ++j) acc[j] = 0.f;
        const float* wrow = WS + (size_t)g * 16384 + tt * 128;
        for (int s = 0; s <= tt; ++s) { const float w = wrow[s] * RS[c0 + s];
            const v4u x = *(const v4u*)(ZZ + (size_t)(c0 + s) * 8192 + U_W + g * 512 + 8 * c.lane); const unsigned xw[4] = {x.x, x.y, x.z, x.w};
#pragma unroll
            for (int j = 0; j < 4; ++j) { acc[2 * j] += w * bf_lo(xw[j]); acc[2 * j + 1] += w * bf_hi(xw[j]); } }
        const v4u uu = *(const v4u*)(ZZ + (size_t)t * 8192 + g * 512 + 8 * c.lane); const unsigned uw[4] = {uu.x, uu.y, uu.z, uu.w};
        const float b = BS[g * 128 + tt]; const float* nwp = nw + g * 512 + 8 * c.lane;
        v4u o; unsigned ow[4];
#pragma unroll
        for (int j = 0; j < 4; ++j) ow[j] = pk2(bf_lo(uw[j]) * (acc[2 * j] * nwp[2 * j] + b), bf_hi(uw[j]) * (acc[2 * j + 1] * nwp[2 * j + 1] + b));
        o.x = ow[0]; o.y = ow[1]; o.z = ow[2]; o.w = ow[3];
        *(v4u*)(MIX + (size_t)t * U_W + g * 512 + 8 * c.lane) = o;
    }
}
typedef short bf16x8 __attribute__((ext_vector_type(8)));
typedef short s16x4 __attribute__((ext_vector_type(4)));
#define MFMA16(a, b, c) __builtin_amdgcn_mfma_f32_16x16x32_bf16((a), (b), (c), 0, 0, 0)
__device__ __forceinline__ bf16x8 frag_rm(const LAS unsigned char* base, int pitch, int r0, int k0, int lane) {
    return *(const LAS bf16x8*)(base + (r0 + (lane & 15)) * pitch + (k0 + 8 * (lane >> 4)) * 2);
}
__device__ __forceinline__ bf16x8 frag_tr(const LAS unsigned char* base, int pitch, int k0, int c0, int lane) {
    const int g = lane >> 4, q = (lane & 15) >> 2, p = lane & 3;
    const LAS unsigned char* a = base + (k0 + 8 * g + q) * pitch + (c0 + 4 * p) * 2;
    const s16x4 lo = __builtin_amdgcn_ds_read_tr16_b64_v4i16((LAS s16x4*)a);
    const s16x4 hi = __builtin_amdgcn_ds_read_tr16_b64_v4i16((LAS s16x4*)(a + 4 * pitch));
    return (bf16x8){lo[0], lo[1], lo[2], lo[3], hi[0], hi[1], hi[2], hi[3]};
}
__device__ __forceinline__ bf16x8 frag_gl(const bf16* T, size_t ld, int c0, int k0, int lane) {
    return *(const bf16x8*)(T + (size_t)(c0 + (lane & 15)) * ld + k0 + 8 * (lane >> 4));
}
constexpr int QT_PITCH = 144, QT_BYTES = 32 * QT_PITCH;
__device__ __forceinline__ void stage_qtile(LAS unsigned char* xt, const bf16* src, size_t ld, int lane) {
    v4u x[4];
#pragma unroll
    for (int i = 0; i < 4; ++i) x[i] = *(const v4u*)(src + (size_t)((lane >> 3) + 8 * i) * ld + 8 * (lane & 7));
#pragma unroll
    for (int i = 0; i < 4; ++i) *(LAS v4u*)(xt + ((lane >> 3) + 8 * i) * QT_PITCH + 16 * (lane & 7)) = x[i];
}

__device__ __forceinline__ int opaque_v(int x) { asm volatile("" : "+v"(x)); return x; }

__device__ __forceinline__ void sgu_mix(const Ctx& c_, LAS unsigned char* lds, const bf16* ZZ, const float* RS, const float* WS, const float* BS, const float* nw, bf16* MIX) {
    constexpr int WP = 272;
    LAS unsigned char* Wt = lds; LAS unsigned char* xt = lds + 128 * WP + c_.wave * QT_BYTES;
    for (int unit = c_.vcu; unit < (SEQ / U_Q) * U_G; unit += c_.G) {
        const int g = unit & 7, t0 = (unit >> 3) * U_Q;
        Ctx c = c_; c.lane = opaque_v(c_.lane); c.tid = opaque_v(c_.tid);
        for (int it = c.tid; it < 128 * 16; it += NWAVES * 64) {
            const int t = it >> 4, s8 = (it & 15) * 8;
            const f32x4 w0 = *(const f32x4*)(WS + (size_t)g * 16384 + t * 128 + s8), w1 = *(const f32x4*)(WS + (size_t)g * 16384 + t * 128 + s8 + 4);
            const f32x4 r0 = *(const f32x4*)(RS + t0 + s8), r1 = *(const f32x4*)(RS + t0 + s8 + 4);
            float v[8] = {w0.x * r0.x, w0.y * r0.y, w0.z * r0.z, w0.w * r0.w, w1.x * r1.x, w1.y * r1.y, w1.z * r1.z, w1.w * r1.w};
#pragma unroll
            for (int j = 0; j < 8; ++j) v[j] = (s8 + j <= t) ? v[j] : 0.f;
            v4u o; o.x = pk2(v[0], v[1]); o.y = pk2(v[2], v[3]); o.z = pk2(v[4], v[5]); o.w = pk2(v[6], v[7]);
            *(LAS v4u*)(Wt + t * WP + s8 * 2) = o;
        }
        __syncthreads();
        const int d0 = g * U_GD + c.wave * 64;
        f32x4 acc[8][4];
#pragma unroll
        for (int a = 0; a < 8; ++a)
#pragma unroll
            for (int b = 0; b < 4; ++b) acc[a][b] = (f32x4){0.f, 0.f, 0.f, 0.f};
#pragma unroll
        for (int ks = 0; ks < 4; ++ks) {
            stage_qtile(xt, ZZ + (size_t)(t0 + 32 * ks) * (2 * U_W) + U_W + d0, 2 * U_W, c.lane);
            bf16x8 bfr[4];
#pragma unroll
            for (int dt = 0; dt < 4; ++dt) bfr[dt] = frag_tr(xt, QT_PITCH, 0, 16 * dt, c.lane);
#pragma unroll
            for (int tt = 2 * ks; tt < 8; ++tt) {
                const bf16x8 a = frag_rm(Wt, WP, 16 * tt, 32 * ks, c.lane);
#pragma unroll
                for (int dt = 0; dt < 4; ++dt) acc[tt][dt] = MFMA16(bfr[dt], a, acc[tt][dt]);
            }
        }
        const int gq = c.lane >> 4, r = c.lane & 15;
#pragma unroll
        for (int tt = 0; tt < 8; ++tt) { const int tl = 16 * tt + r; const size_t t = t0 + tl; const float b = BS[g * 128 + tl];
#pragma unroll
            for (int dt = 0; dt < 4; ++dt) { const int col = d0 + 16 * dt + 4 * gq;
                const v2u u = *(const v2u*)(ZZ + t * (2 * U_W) + col); const f32x4 w4 = *(const f32x4*)(nw + col); const f32x4 a4 = acc[tt][dt];
                v2u o; o.x = pk2(bf_lo(u.x) * (a4.x * w4.x + b), bf_hi(u.x) * (a4.y * w4.y + b)); o.y = pk2(bf_lo(u.y) * (a4.z * w4.z + b), bf_hi(u.y) * (a4.w * w4.w + b));
                *(v2u*)(MIX + t * U_W + col) = o; } }
        __syncthreads();
    }
}
__device__ __forceinline__ float wave_incl_scan(float x, int lane) {
#pragma unroll
    for (int o = 1; o < 64; o <<= 1) { const float n = __shfl_up(x, o); if (lane >= o) x += n; }
    return x;
}
__device__ __forceinline__ float ssd_dt_acum(const float* DT, const float* a_log, int t0, int h, int lane, LAS float* AC, LAS float* DTL) {
    const float a = -__expf(a_log[h]);
    const float d0 = DT[(size_t)(t0 + 2 * lane) * 64 + h], d1 = DT[(size_t)(t0 + 2 * lane + 1) * 64 + h];
    const float e0 = d0 * a, e1 = d1 * a;
    const float incl = wave_incl_scan(e0 + e1, lane);
    AC[2 * lane] = incl - e1; AC[2 * lane + 1] = incl; DTL[2 * lane] = d0; DTL[2 * lane + 1] = d1;
    return __shfl(incl, 63);
}
constexpr int SS_TP = 272, SS_TILE = 128 * SS_TP;

__device__ __forceinline__ void ssd_states(const Ctx& c_, LAS unsigned char* lds, const bf16* XC, const float* DT, const float* a_log, float* ST, float* CD) {
    LAS unsigned char* Bt = lds; LAS unsigned char* xt = lds + SS_TILE + c_.wave * QT_BYTES;
    LAS float* AC = (LAS float*)(lds + SS_TILE + 8 * QT_BYTES + c_.wave * 1024); LAS float* DTL = AC + 128;
    for (int unit = c_.vcu; unit < (SEQ / 128) * S_G; unit += c_.G) {
        Ctx c = c_; c.lane = opaque_v(c_.lane); c.tid = opaque_v(c_.tid);
        const int g = unit & 7, cc = unit >> 3, t0 = cc * 128, h = g * 8 + c.wave;
        for (int it = c.tid; it < 128 * 16; it += NWAVES * 64) { const int row = it >> 4, ch = it & 15;
            *(LAS v4u*)(Bt + row * SS_TP + ch * 16) = *(const v4u*)(XC + (size_t)(t0 + row) * S_CONVD + S_DI + g * S_N + ch * 8); }
        const float aend = ssd_dt_acum(DT, a_log, t0, h, c.lane, AC, DTL);
        if (c.lane == 0) CD[cc * 64 + h] = __expf(aend);
        __syncthreads();
        f32x4 acc[4][8];
#pragma unroll
        for (int a = 0; a < 4; ++a)
#pragma unroll
            for (int b = 0; b < 8; ++b) acc[a][b] = (f32x4){0.f, 0.f, 0.f, 0.f};
#pragma unroll
        for (int ks = 0; ks < 4; ++ks) {
            {
                v4u x[4];
#pragma unroll
                for (int i = 0; i < 4; ++i) x[i] = *(const v4u*)(XC + (size_t)(t0 + 32 * ks + (c.lane >> 3) + 8 * i) * S_CONVD + h * 64 + 8 * (c.lane & 7));
#pragma unroll
                for (int i = 0; i < 4; ++i) { const int s = 32 * ks + (c.lane >> 3) + 8 * i; const float w = DTL[s] * __expf(aend - AC[s]);
                    v4u o; o.x = pk2(bf_lo(x[i].x) * w, bf_hi(x[i].x) * w); o.y = pk2(bf_lo(x[i].y) * w, bf_hi(x[i].y) * w); o.z = pk2(bf_lo(x[i].z) * w, bf_hi(x[i].z) * w); o.w = pk2(bf_lo(x[i].w) * w, bf_hi(x[i].w) * w);
                    *(LAS v4u*)(xt + ((c.lane >> 3) + 8 * i) * QT_PITCH + 16 * (c.lane & 7)) = o; }
            }
            bf16x8 afr[4];
#pragma unroll
            for (int pt = 0; pt < 4; ++pt) afr[pt] = frag_tr(xt, QT_PITCH, 0, 16 * pt, c.lane);
#pragma unroll
            for (int nt = 0; nt < 8; ++nt) { const bf16x8 b = frag_tr(Bt, SS_TP, 32 * ks, 16 * nt, c.lane);
#pragma unroll
                for (int pt = 0; pt < 4; ++pt) acc[pt][nt] = MFMA16(b, afr[pt], acc[pt][nt]); }
        }
        float* stb = ST + ((size_t)(cc * 64 + h) * 64) * 128;
        const int gq = c.lane >> 4, r = c.lane & 15;
#pragma unroll
        for (int pt = 0; pt < 4; ++pt)
#pragma unroll
            for (int nt = 0; nt < 8; ++nt) *(f32x4*)(stb + (16 * pt + r) * 128 + 16 * nt + 4 * gq) = acc[pt][nt];
        __syncthreads();
    }
}
__device__ __forceinline__ void ssd_chunk_scan(const Ctx& c, const float* ST, const float* CD, bf16* PV) {
    constexpr int NV = 64 * 64 * 128 / 4, CS = 64 * 64 * 128;
    for (int idx = c.gtid; idx < NV; idx += c.NT) {
        const int h = idx >> 11; f32x4 st = (f32x4){0.f, 0.f, 0.f, 0.f};
        for (int c0 = 0; c0 < 64; c0 += 8) {
            f32x4 s[8]; float d[8];
#pragma unroll
            for (int j = 0; j < 8; ++j) { s[j] = *(const f32x4*)(ST + (size_t)(c0 + j) * CS + (size_t)idx * 4); d[j] = CD[(c0 + j) * 64 + h]; }
#pragma unroll
            for (int j = 0; j < 8; ++j) { v2u o; o.x = pk2(st.x, st.y); o.y = pk2(st.z, st.w); *(v2u*)(PV + (size_t)(c0 + j) * CS + (size_t)idx * 4) = o; st = st * d[j] + s[j]; }
        }
    }
}
__device__ __forceinline__ void ssd_out(const Ctx& c_, LAS unsigned char* lds, const bf16* XC, const bf16* ZX, const float* DT, const float* a_log, const float* dskip, const bf16* PV, const float* nw, bf16* MIX) {
    LAS unsigned char* Ct = lds; LAS unsigned char* Bt = lds + SS_TILE; LAS unsigned char* xt = lds + 2 * SS_TILE + c_.wave * QT_BYTES;
    LAS float* AC = (LAS float*)(lds + 2 * SS_TILE + 8 * QT_BYTES + c_.wave * 1024); LAS float* DTL = AC + 128;
    LAS float* RSS = (LAS float*)(lds + 2 * SS_TILE + 8 * QT_BYTES + 8 * 1024);
    for (int unit = c_.vcu; unit < (SEQ / 128) * S_G; unit += c_.G) {
        Ctx c = c_; c.lane = opaque_v(c_.lane); c.tid = opaque_v(c_.tid);
        const int gq = c.lane >> 4, r = c.lane & 15;
        const int g = unit & 7, cc = unit >> 3, t0 = cc * 128, h = g * 8 + c.wave;
        for (int it = c.tid; it < 128 * 16; it += NWAVES * 64) { const int row = it >> 4, ch = it & 15; const bf16* src = XC + (size_t)(t0 + row) * S_CONVD + S_DI + g * S_N + ch * 8;
            *(LAS v4u*)(Bt + row * SS_TP + ch * 16) = *(const v4u*)src; *(LAS v4u*)(Ct + row * SS_TP + ch * 16) = *(const v4u*)(src + S_G * S_N); }
        (void)ssd_dt_acum(DT, a_log, t0, h, c.lane, AC, DTL);
        const float Dh = dskip[h];
        __syncthreads();
        {
            f32x4 cb[8];
#pragma unroll
            for (int st = 0; st < 8; ++st) cb[st] = (f32x4){0.f, 0.f, 0.f, 0.f};
#pragma unroll
            for (int ks = 0; ks < 4; ++ks) { const bf16x8 a = frag_rm(Ct, SS_TP, 16 * c.wave, 32 * ks, c.lane);
#pragma unroll
                for (int st = 0; st < 8; ++st) if (st <= c.wave) { const bf16x8 b = frag_rm(Bt, SS_TP, 16 * st, 32 * ks, c.lane); cb[st] = MFMA16(a, b, cb[st]); } }
            __syncthreads();
#pragma unroll
            for (int st = 0; st < 8; ++st) if (st <= c.wave) {
#pragma unroll
                for (int i = 0; i < 4; ++i) *(LAS bf16*)(Bt + (16 * c.wave + 4 * gq + i) * SS_TP + (16 * st + r) * 2) = (bf16)f2bf(cb[st][i]); }
            __syncthreads();
        }
#pragma unroll 1
        for (int hb = 0; hb < 2; ++hb) {
        Ctx c = c_; c.lane = opaque_v(c_.lane);
        const int gq = c.lane >> 4, r = c.lane & 15;
        f32x4 acc[4][4];
#pragma unroll
        for (int a = 0; a < 4; ++a)
#pragma unroll
            for (int b = 0; b < 4; ++b) acc[a][b] = (f32x4){0.f, 0.f, 0.f, 0.f};
        {
            const bf16* pvb = PV + ((size_t)(cc * 64 + h) * 64) * 128;
#pragma unroll
            for (int ks = 0; ks < 4; ++ks) { bf16x8 bfr[4];
#pragma unroll
                for (int pt = 0; pt < 4; ++pt) bfr[pt] = frag_gl(pvb, 128, 16 * pt, 32 * ks, c.lane);
#pragma unroll
                for (int tl = 0; tl < 4; ++tl) { const bf16x8 a = frag_rm(Ct, SS_TP, 64 * hb + 16 * tl, 32 * ks, c.lane);
#pragma unroll
                    for (int pt = 0; pt < 4; ++pt) acc[tl][pt] = MFMA16(bfr[pt], a, acc[tl][pt]); } }
#pragma unroll
            for (int tl = 0; tl < 4; ++tl) { const float e = __expf(AC[64 * hb + 16 * tl + r]);
#pragma unroll
                for (int pt = 0; pt < 4; ++pt) acc[tl][pt] *= e; }
        }
#pragma unroll
        for (int ks = 0; ks < 4; ++ks) if (ks < 2 * hb + 2) {
            stage_qtile(xt, XC + (size_t)(t0 + 32 * ks) * S_CONVD + h * 64, S_CONVD, c.lane);
            bf16x8 bfr[4];
#pragma unroll
            for (int pt = 0; pt < 4; ++pt) bfr[pt] = frag_tr(xt, QT_PITCH, 0, 16 * pt, c.lane);
            float acs[8], dts[8];
#pragma unroll
            for (int j = 0; j < 8; ++j) { acs[j] = AC[32 * ks + 8 * gq + j]; dts[j] = DTL[32 * ks + 8 * gq + j]; }
#pragma unroll
            for (int tl = 0; tl < 4; ++tl) if (4 * hb + tl >= 2 * ks) {
                const int trow = 64 * hb + 16 * tl + r; const float act = AC[trow];
                const v4u cw = *(const LAS v4u*)(Bt + trow * SS_TP + (32 * ks + 8 * gq) * 2);
                const float cbv[8] = {bf_lo(cw.x), bf_hi(cw.x), bf_lo(cw.y), bf_hi(cw.y), bf_lo(cw.z), bf_hi(cw.z), bf_lo(cw.w), bf_hi(cw.w)};
                float v[8];
#pragma unroll
                for (int j = 0; j < 8; ++j) { const int sj = 32 * ks + 8 * gq + j; float x = cbv[j] * __expf(act - acs[j]) * dts[j]; x = (sj <= trow) ? x : 0.f; v[j] = (sj == trow) ? x + Dh : x; }
                v4u aw; aw.x = pk2(v[0], v[1]); aw.y = pk2(v[2], v[3]); aw.z = pk2(v[4], v[5]); aw.w = pk2(v[6], v[7]);
                const bf16x8 a = __builtin_bit_cast(bf16x8, aw);
#pragma unroll
                for (int pt = 0; pt < 4; ++pt) acc[tl][pt] = MFMA16(bfr[pt], a, acc[tl][pt]);
            }
        }
#pragma unroll
        for (int tl = 0; tl < 4; ++tl) { const int tr = 64 * hb + 16 * tl + r; float ssq = 0.f;
#pragma unroll
            for (int pt = 0; pt < 4; ++pt) { const v2u z = *(const v2u*)(ZX + (size_t)(t0 + tr) * S_ZX + h * 64 + 16 * pt + 4 * gq);
                f32x4 v = acc[tl][pt]; v.x *= silu(bf_lo(z.x)); v.y *= silu(bf_hi(z.x)); v.z *= silu(bf_lo(z.y)); v.w *= silu(bf_hi(z.y)); acc[tl][pt] = v;
                ssq += (v.x * v.x + v.y * v.y) + (v.z * v.z + v.w * v.w); }
            ssq += __shfl_xor(ssq, 16); ssq += __shfl_xor(ssq, 32);
            if (gq == 0) RSS[c.wave * 128 + tr] = ssq; }
        __syncthreads();
#pragma unroll
        for (int tl = 0; tl < 4; ++tl) { const int tr = 64 * hb + 16 * tl + r; float tot = 0.f;
#pragma unroll
            for (int w = 0; w < 8; ++w) tot += RSS[w * 128 + tr];
            const float rs = rsqrtf(tot * (1.f / 512.f) + EPS);
#pragma unroll
            for (int pt = 0; pt < 4; ++pt) { const int col = h * 64 + 16 * pt + 4 * gq; const f32x4 w4 = *(const f32x4*)(nw + col); const f32x4 v = acc[tl][pt] * rs;
                v2u o; o.x = pk2(v.x * w4.x, v.y * w4.y); o.y = pk2(v.z * w4.z, v.w * w4.w); *(v2u*)(MIX + (size_t)(t0 + tr) * S_DI + col) = o; } }
        }
        __syncthreads();
    }
}
__device__ __forceinline__ void gla_bcum(const Ctx& c, const float* GL, const float* w2, const float* bg, float* BC) {
    for (int idx = c.gtid; idx < (SEQ / 64) * G_DK; idx += c.NT) {
        const int cc = idx >> 10, col = idx & 1023; float w[16];
#pragma unroll
        for (int r = 0; r < 16; ++r) w[r] = w2[r * G_DK + col];
        const float b = bg[col]; float acc = 0.f;
        for (int t = 0; t < 64; ++t) { const f32x4* gp = (const f32x4*)(GL + (size_t)(cc * 64 + t) * 16); const f32x4 g0 = gp[0], g1 = gp[1], g2 = gp[2], g3 = gp[3];
            float x = b;
            x += g0.x * w[0] + g0.y * w[1] + g0.z * w[2] + g0.w * w[3]; x += g1.x * w[4] + g1.y * w[5] + g1.z * w[6] + g1.w * w[7];
            x += g2.x * w[8] + g2.y * w[9] + g2.z * w[10] + g2.w * w[11]; x += g3.x * w[12] + g3.y * w[13] + g3.z * w[14] + g3.w * w[15];
            acc += -softplus(-x) * (1.f / 16.f);
            BC[(size_t)(cc * 64 + t) * G_DK + col] = acc; }
    }
}
constexpr int GK_P = 528, GK_TILE = 64 * GK_P;
constexpr int GV_P = 144, GV_TILE = 64 * GV_P;
__device__ __forceinline__ v4u scale8(const v4u x, const f32x4 e0, const f32x4 e1) {
    v4u o; o.x = pk2(bf_lo(x.x) * e0.x, bf_hi(x.x) * e0.y); o.y = pk2(bf_lo(x.y) * e0.z, bf_hi(x.y) * e0.w); o.z = pk2(bf_lo(x.z) * e1.x, bf_hi(x.z) * e1.y); o.w = pk2(bf_lo(x.w) * e1.z, bf_hi(x.w) * e1.w); return o;
}
__device__ __forceinline__ f32x4 exp4(const f32x4 a) { return (f32x4){__expf(a.x), __expf(a.y), __expf(a.z), __expf(a.w)}; }
__device__ __forceinline__ void gla_states(const Ctx& c_, LAS unsigned char* lds, const bf16* QKVR, const float* BC, float* KV) {
    LAS unsigned char* Kt = lds; LAS unsigned char* vt = lds + GK_TILE + c_.wave * GV_TILE;
    for (int unit = c_.vcu; unit < (SEQ / 64) * G_H; unit += c_.G) {
        Ctx c = c_; c.lane = opaque_v(c_.lane); c.tid = opaque_v(c_.tid);
        const int h = unit & 3, cc = unit >> 2, t0 = cc * 64;
        for (int it = c.tid; it < 64 * 32; it += NWAVES * 64) { const int s = it >> 5, ch = it & 31;
            const v4u x = *(const v4u*)(QKVR + (size_t)(t0 + s) * G_QKVR + G_DK + h * G_HK + 8 * ch);
            const float* bs = BC + (size_t)(t0 + s) * G_DK + h * G_HK + 8 * ch; const float* be = BC + (size_t)(t0 + 63) * G_DK + h * G_HK + 8 * ch;
            const f32x4 e0 = exp4(*(const f32x4*)be - *(const f32x4*)bs), e1 = exp4(*(const f32x4*)(be + 4) - *(const f32x4*)(bs + 4));
            *(LAS v4u*)(Kt + s * GK_P + ch * 16) = scale8(x, e0, e1); }
        { const bf16* vsrc = QKVR + (size_t)t0 * G_QKVR + 2 * G_DK + h * G_HV + c.wave * 64;
          stage_qtile(vt, vsrc, G_QKVR, c.lane); stage_qtile(vt + 32 * GV_P, vsrc + (size_t)32 * G_QKVR, G_QKVR, c.lane); }
        __syncthreads();
#pragma unroll 1
        for (int kh = 0; kh < 2; ++kh) {
            const int lane = opaque_v(c.lane), gq = lane >> 4, r = lane & 15;
            f32x4 acc[4][8];
#pragma unroll
            for (int a = 0; a < 4; ++a)
#pragma unroll
                for (int b = 0; b < 8; ++b) acc[a][b] = (f32x4){0.f, 0.f, 0.f, 0.f};
#pragma unroll
            for (int ks = 0; ks < 2; ++ks) { bf16x8 afr[4];
#pragma unroll
                for (int v4 = 0; v4 < 4; ++v4) afr[v4] = frag_tr(vt, GV_P, 32 * ks, 16 * v4, lane);
#pragma unroll
                for (int kt = 0; kt < 8; ++kt) { const bf16x8 b = frag_tr(Kt, GK_P, 32 * ks, 128 * kh + 16 * kt, lane);
#pragma unroll
                    for (int v4 = 0; v4 < 4; ++v4) acc[v4][kt] = MFMA16(b, afr[v4], acc[v4][kt]); } }
            float* kvb = KV + ((size_t)(cc * 4 + h) * G_HV + c.wave * 64) * G_HK + 128 * kh;
#pragma unroll
            for (int v4 = 0; v4 < 4; ++v4)
#pragma unroll
                for (int kt = 0; kt < 8; ++kt) *(f32x4*)(kvb + (size_t)(16 * v4 + r) * G_HK + 16 * kt + 4 * gq) = acc[v4][kt];
        }
        __syncthreads();
    }
}
__device__ __forceinline__ void gla_chunk_scan(const Ctx& c, const float* KV, const float* BC, bf16* SP) {
    constexpr int NV = G_H * G_HV * G_HK / 4, CS = G_H * G_HV * G_HK;
    for (int idx = c.gtid; idx < NV; idx += c.NT) {
        const int h = idx >> 15, k = (idx & 63) * 4; f32x4 st = (f32x4){0.f, 0.f, 0.f, 0.f};
        for (int c0 = 0; c0 < SEQ / 64; c0 += 8) {
            f32x4 s[8], d[8];
#pragma unroll
            for (int j = 0; j < 8; ++j) { s[j] = *(const f32x4*)(KV + (size_t)(c0 + j) * CS + (size_t)idx * 4); d[j] = *(const f32x4*)(BC + (size_t)((c0 + j) * 64 + 63) * G_DK + h * G_HK + k); }
#pragma unroll
            for (int j = 0; j < 8; ++j) { v2u o; o.x = pk2(st.x, st.y); o.y = pk2(st.z, st.w); *(v2u*)(SP + (size_t)(c0 + j) * CS + (size_t)idx * 4) = o; st = st * exp4(d[j]) + s[j]; }
        }
    }
}
__device__ __forceinline__ void gla_out(const Ctx& c_, LAS unsigned char* lds, const bf16* QKVR, const float* BC, const bf16* SP, const float* nw, bf16* MIX) {
    LAS unsigned char* Qt = lds; LAS unsigned char* Kt = lds + GK_TILE; LAS unsigned char* At = lds + 2 * GK_TILE; LAS unsigned char* vt = lds + 2 * GK_TILE + GV_TILE + c_.wave * GV_TILE;
    LAS float* RSS = (LAS float*)(lds + 2 * GK_TILE + 9 * GV_TILE);
    for (int unit = c_.vcu; unit < (SEQ / 64) * G_H; unit += c_.G) {
        Ctx c = c_; c.lane = opaque_v(c_.lane); c.tid = opaque_v(c_.tid);
        const int gq = c.lane >> 4, r = c.lane & 15;
        const int h = unit & 3, cc = unit >> 2, t0 = cc * 64;
        for (int it = c.tid; it < 64 * 32; it += NWAVES * 64) { const int s = it >> 5, ch = it & 31;
            const bf16* qp = QKVR + (size_t)(t0 + s) * G_QKVR + h * G_HK + 8 * ch;
            const v4u xq = *(const v4u*)qp, xk = *(const v4u*)(qp + G_DK);
            const float* bs = BC + (size_t)(t0 + s) * G_DK + h * G_HK + 8 * ch;
            const f32x4 b0 = *(const f32x4*)bs, b1 = *(const f32x4*)(bs + 4);
            *(LAS v4u*)(Qt + s * GK_P + ch * 16) = scale8(xq, exp4(b0) * (1.f / 16.f), exp4(b1) * (1.f / 16.f));
            *(LAS v4u*)(Kt + s * GK_P + ch * 16) = scale8(xk, exp4(-b0), exp4(-b1)); }
        { const bf16* vsrc = QKVR + (size_t)t0 * G_QKVR + 2 * G_DK + h * G_HV + c.wave * 64;
          stage_qtile(vt, vsrc, G_QKVR, c.lane); stage_qtile(vt + 32 * GV_P, vsrc + (size_t)32 * G_QKVR, G_QKVR, c.lane); }
        __syncthreads();
#pragma unroll 1
        for (int rep = 0; rep < 2; ++rep) {
            const int lane = opaque_v(c.lane), gq2 = lane >> 4, r2 = lane & 15;
            const int id = c.wave + 8 * rep, tt = id >> 2, st = id & 3;
            f32x4 a4 = (f32x4){0.f, 0.f, 0.f, 0.f};
            if (st <= tt) {
#pragma unroll
                for (int ks = 0; ks < 8; ++ks) a4 = MFMA16(frag_rm(Qt, GK_P, 16 * tt, 32 * ks, lane), frag_rm(Kt, GK_P, 16 * st, 32 * ks, lane), a4);
            }
#pragma unroll
            for (int i = 0; i < 4; ++i) { const int tr = 16 * tt + 4 * gq2 + i, sc = 16 * st + r2; *(LAS bf16*)(At + tr * GV_P + sc * 2) = (bf16)f2bf(sc <= tr ? a4[i] : 0.f); }
        }
        __syncthreads();
        f32x4 acc[4][4];
#pragma unroll
        for (int a = 0; a < 4; ++a)
#pragma unroll
            for (int b = 0; b < 4; ++b) acc[a][b] = (f32x4){0.f, 0.f, 0.f, 0.f};
#pragma unroll
        for (int ks = 0; ks < 2; ++ks) { bf16x8 bfr[4];
#pragma unroll
            for (int v4 = 0; v4 < 4; ++v4) bfr[v4] = frag_tr(vt, GV_P, 32 * ks, 16 * v4, c.lane);
#pragma unroll
            for (int tt = 2 * ks; tt < 4; ++tt) { const bf16x8 a = frag_rm(At, GV_P, 16 * tt, 32 * ks, c.lane);
#pragma unroll
                for (int v4 = 0; v4 < 4; ++v4) acc[tt][v4] = MFMA16(bfr[v4], a, acc[tt][v4]); } }
        { const bf16* spb = SP + ((size_t)(cc * 4 + h) * G_HV + c.wave * 64) * G_HK;
#pragma unroll
          for (int ks = 0; ks < 8; ++ks) { bf16x8 bfr[4];
#pragma unroll
            for (int v4 = 0; v4 < 4; ++v4) bfr[v4] = frag_gl(spb, G_HK, 16 * v4, 32 * ks, c.lane);
#pragma unroll
            for (int tt = 0; tt < 4; ++tt) { const bf16x8 a = frag_rm(Qt, GK_P, 16 * tt, 32 * ks, c.lane);
#pragma unroll
                for (int v4 = 0; v4 < 4; ++v4) acc[tt][v4] = MFMA16(bfr[v4], a, acc[tt][v4]); } } }
#pragma unroll
        for (int tt = 0; tt < 4; ++tt) { float ssq = 0.f;
#pragma unroll
            for (int v4 = 0; v4 < 4; ++v4) { const f32x4 v = acc[tt][v4]; ssq += (v.x * v.x + v.y * v.y) + (v.z * v.z + v.w * v.w); }
            ssq += __shfl_xor(ssq, 16); ssq += __shfl_xor(ssq, 32);
            if (gq == 0) RSS[c.wave * 64 + 16 * tt + r] = ssq; }
        __syncthreads();
#pragma unroll
        for (int tt = 0; tt < 4; ++tt) { const int tr = 16 * tt + r; float tot = 0.f;
#pragma unroll
            for (int w = 0; w < 8; ++w) tot += RSS[w * 64 + tr];
            const float rs = rsqrtf(tot * (1.f / 512.f) + EPS);
#pragma unroll
            for (int v4 = 0; v4 < 4; ++v4) { const int vc = c.wave * 64 + 16 * v4 + 4 * gq;
                const v2u rg = *(const v2u*)(QKVR + (size_t)(t0 + tr) * G_QKVR + 2 * G_DK + G_DV + h * G_HV + vc); const f32x4 w4 = *(const f32x4*)(nw + vc); const f32x4 v = acc[tt][v4] * rs;
                v2u o; o.x = pk2(v.x * w4.x * silu(bf_lo(rg.x)), v.y * w4.y * silu(bf_hi(rg.x))); o.y = pk2(v.z * w4.z * silu(bf_lo(rg.y)), v.w * w4.w * silu(bf_hi(rg.y)));
                *(v2u*)(MIX + (size_t)(t0 + tr) * G_DV + h * G_HV + vc) = o; } }
        __syncthreads();
    }
}
constexpr int NPH = 86, PH_FINAL = 85;
enum { KIND_SSD = 0, KIND_GLA = 1, KIND_SGU = 2, KIND_FFN = 3 };
__host__ __device__ inline int step_kind(int s) { return (s % 3 == 1) ? ((s / 3) % 3) : KIND_FFN; }
__host__ __device__ inline bool slot_used(int k) {
    if (k == 0 || k == PH_FINAL) return true;
    const int s = (k - 1) / 7, j = (k - 1) % 7, kind = step_kind(s);
    if (j == 0) return false;
    if (kind == KIND_FFN) return j == 1 || j == 6;
    if (kind == KIND_SGU) return j <= 3 || j == 6;
    return true;
}
__device__ __forceinline__ int opaque_idx(int i) { asm volatile("" : "+s"(i)); return i; }
struct Args { const float* in[25]; float* out; unsigned char* ws; int ph_lo, ph_hi; };

__global__ void __launch_bounds__(NWAVES * 64, 2) mk_fwd(Args args) {
    extern __shared__ __attribute__((aligned(16))) unsigned char lds_raw[];
    LAS unsigned char* lds = (LAS unsigned char*)lds_raw;
    volatile LAS unsigned* MISC = (volatile LAS unsigned*)(lds + MISC_OFF);
    Ctx c0; c0.tid = threadIdx.x; c0.lane = c0.tid & 63; c0.wave = __builtin_amdgcn_readfirstlane(c0.tid >> 6);
    c0.G = gridDim.x; { const int bx = blockIdx.x; c0.vcu = (c0.G % 8 == 0) ? (bx % 8) * (c0.G / 8) + bx / 8 : bx; }
    c0.gw = c0.vcu * NWAVES + c0.wave; c0.NGW = c0.G * NWAVES; c0.gtid = c0.vcu * (NWAVES * 64) + c0.tid; c0.NT = c0.G * NWAVES * 64;
    unsigned char* ws = args.ws;
    unsigned* ctl = (unsigned*)(ws + WS_CTL);
    for (int u = c0.tid; u < (LDS_BYTES - LDSCTL_OFF) / 4; u += NWAVES * 64) ((LAS unsigned*)(lds + LDSCTL_OFF))[u] = 0u;
    __syncthreads();
    const int lo = args.ph_lo, hi = args.ph_hi;
    const bool fused = (hi - lo) > 1;
    XcdBarrier bar; bar.bar = ctl + CW_BAR; bar.x = 0; bar.st = nullptr;
    if (fused) bar = xcd_barrier_post(ctl + CW_BAR, MISC + 8);
#define IN(k) (lo <= (k) && (k) < hi)
#define SEAM() do { if (fused) xcd_barrier(bar); } while (0)
#define FRESH() Ctx c = c0; asm volatile("" : "+v"(c.tid), "+v"(c.lane), "+v"(c.gtid)); asm volatile("" : "+s"(c.gw), "+s"(c.NGW), "+s"(c.NT))
#define INP(i) (args.in[opaque_idx(i)])
#define REP(bit) for (int rep_ = 0; rep_ < ((PROBE_DUP >> (bit)) & 1) + 1; ++rep_)

    float* H = (float*)(ws + WS_H); bf16* HN = (bf16*)(ws + WS_HN); bf16* BIG = (bf16*)(ws + WS_BIG); bf16* MIX = (bf16*)(ws + WS_MIX);
    unsigned char* scr = ws + WS_SCR; float* PS = (float*)(ws + WS_PS);

    if (IN(0)) REP(0) {
        FRESH();
        for (int i = 0; i < 8; ++i) {
            convert_matrix<1>(c, INP(2) + (size_t)i * DM * 2 * DFF, DM, 2 * DFF, 2 * DFF, (bf16*)(ws + WS_W_FFN_IN + i * SZ_FFN_IN));
            convert_matrix<0>(c, INP(3) + (size_t)i * DFF * DM, DFF, DM, DM, (bf16*)(ws + WS_W_FFN_OUT + i * SZ_FFN_OUT));
        }
        for (int i = 0; i < 2; ++i) {
            convert_matrix<0>(c, INP(5) + (size_t)i * DM * S_IN, DM, S_IN, S_INP, (bf16*)(ws + WS_W_SSD_IN + i * SZ_SSD_IN));
            convert_matrix<0>(c, INP(12) + (size_t)i * S_DI * DM, S_DI, DM, DM, (bf16*)(ws + WS_W_SSD_OUT + i * SZ_SSD_OUT));
        }
        convert_matrix<0>(c, INP(13), DM, G_IN, G_INP, (bf16*)(ws + WS_W_GLA_IN));
        convert_matrix<0>(c, INP(17), G_DV, DM, DM, (bf16*)(ws + WS_W_GLA_OUT));
        convert_matrix<0>(c, INP(18), DM, 2 * U_W, 2 * U_W, (bf16*)(ws + WS_W_SGU_IN));
        convert_matrix<0>(c, INP(23), U_W, DM, DM, (bf16*)(ws + WS_W_SGU_OUT));
        init_rows(c, INP(0), INP(1), H, HN, PS);
        SEAM();
    }

    for (int s = 0; s < 3 * DEPTH; ++s) {
        const int base = 1 + 7 * s, layer = s / 3, sub = s % 3, kind = step_kind(s), mj = layer / 3, fi = layer * 2 + (sub >> 1);
        if (IN(base + 1)) REP(3) {
            LAS float* RSL = (LAS float*)(lds + RING_BYTES);
            if (kind == KIND_FFN) {
                pg8::Gemm g{HN, (const bf16*)(ws + WS_W_FFN_IN + fi * SZ_FFN_IN), SEQ, 2 * DFF, DM}; pg8::StaticOrder S; S.init(SEQ, 2 * DFF, c0.G, (int)blockIdx.x);
                { pg8::Unit u0; S.next(0, u0); pg8::row_scale_table(RSL, PS, u0.pm & 7); }
                pg8::EpiSwiGLU E{BIG, DFF, pg8::RowScale{RSL}};
                pg8::gemm_phase<pg8::EpiSwiGLU, pg8::StaticOrder, true, true>(lds + RING_OFF, g, S, E);
            } else {
                const bf16* W = (const bf16*)(ws + (kind == KIND_SSD ? WS_W_SSD_IN + mj * SZ_SSD_IN : kind == KIND_GLA ? WS_W_GLA_IN : WS_W_SGU_IN));
                const int Np = kind == KIND_SSD ? S_INP : kind == KIND_GLA ? G_INP : 2 * U_W, ldo = kind == KIND_SSD ? S_ZX : kind == KIND_GLA ? G_QKVR : 2 * U_W;
                pg8::Gemm g{HN, W, SEQ, Np, DM}; pg8::StaticOrder S; S.init(SEQ, Np, c0.G, (int)blockIdx.x);
                pg8::EpiBf16X E{BIG, ldo, kind == KIND_SGU ? INP(19) : nullptr, ldo / 256, (float*)(scr + (kind == KIND_SSD ? SC_DTR : SC_GL)), kind == KIND_SSD ? 64 : 16, pg8::RowScale{RSL}};
                { pg8::Unit u0; S.next(0, u0); pg8::row_scale_table(RSL, PS, u0.pm & 7); }
                pg8::gemm_phase<pg8::EpiBf16X, pg8::StaticOrder, true, true>(lds + RING_OFF, g, S, E);
            }
            SEAM();
        }
        if (kind == KIND_SSD) {
            bf16* XC = (bf16*)(scr + SC_XC); float* DTR = (float*)(scr + SC_DTR); float* DT = (float*)(scr + SC_DT); float* ST = (float*)(scr + SC_ST); bf16* PV = (bf16*)(scr + SC_PV); float* CD = (float*)(scr + SC_CD);
            if (IN(base + 2)) REP(5) { FRESH(); ssd_conv_dt(c, BIG, INP(6) + (size_t)mj * S_CONVD * 4, INP(7) + (size_t)mj * S_CONVD, DTR, INP(8) + mj * 64, XC, DT); SEAM(); }
            if (IN(base + 3)) REP(6) { FRESH(); ssd_states(c, lds, XC, DT, INP(9) + mj * 64, ST, CD); SEAM(); }
            if (IN(base + 4)) REP(7) { FRESH(); ssd_chunk_scan(c, ST, CD, PV); SEAM(); }
            if (IN(base + 5)) REP(8) { FRESH(); ssd_out(c, lds, XC, BIG, DT, INP(9) + mj * 64, INP(10) + mj * 64, PV, INP(11) + (size_t)mj * S_DI, MIX); SEAM(); }
        } else if (kind == KIND_GLA) {
            float* GL = (float*)(scr + SC_GL); float* BC = (float*)(scr + SC_BC); float* KV = (float*)(scr + SC_KV); bf16* SP = (bf16*)(scr + SC_SP);
            if (IN(base + 2)) REP(9) { FRESH(); gla_bcum(c, GL, INP(14), INP(15), BC); SEAM(); }
            if (IN(base + 3)) REP(10) { FRESH(); gla_states(c, lds, BIG, BC, KV); SEAM(); }
            if (IN(base + 4)) REP(11) { FRESH(); gla_chunk_scan(c, KV, BC, SP); SEAM(); }
            if (IN(base + 5)) REP(12) { FRESH(); gla_out(c, lds, BIG, BC, SP, INP(16), MIX); SEAM(); }
        } else if (kind == KIND_SGU) {
            float* RS = (float*)(scr + SC_RS);
            if (IN(base + 2)) REP(13) { FRESH(); sgu_rstd(c, BIG, RS); SEAM(); }
            if (IN(base + 3)) REP(14) { FRESH(); sgu_mix(c, lds, BIG, RS, INP(21), INP(22), INP(20), MIX); SEAM(); }
        }
        if (IN(base + 6)) REP(4) {
            const bf16* A = kind == KIND_FFN ? BIG : MIX;
            const bf16* W = (const bf16*)(ws + (kind == KIND_FFN ? WS_W_FFN_OUT + fi * SZ_FFN_OUT : kind == KIND_SSD ? WS_W_SSD_OUT + mj * SZ_SSD_OUT : kind == KIND_GLA ? WS_W_GLA_OUT : WS_W_SGU_OUT));
            const int K = kind == KIND_FFN ? DFF : kind == KIND_GLA ? G_DV : 4096;
            pg8::Gemm g{A, W, SEQ, DM, K}; pg8::StaticOrder S; S.init(SEQ, DM, c0.G, (int)blockIdx.x);
            const int s1 = s + 1, layer1 = s1 / 3, sub1 = s1 % 3;
            const float* gnext = (s1 == 3 * DEPTH) ? INP(24) : (sub1 == 1) ? INP(4) + (size_t)layer1 * DM : INP(1) + (size_t)(layer1 * 2 + (sub1 >> 1)) * DM;
            pg8::EpiResid E{H, DM, rep_ ? 0.f : (kind == KIND_FFN ? 0.5f : 1.0f), gnext, HN, PS};
            pg8::gemm_phase<pg8::EpiResid, pg8::StaticOrder, true, true>(lds + RING_OFF, g, S, E);
            SEAM();
        }
    }
    if (IN(PH_FINAL)) { FRESH(); rmsnorm_rows<false>(c, H, INP(24), args.out); }
#undef IN
#undef SEAM
#undef FRESH
#undef INP
#undef REP
}

extern "C" void kernel_launch(void* const* d_in, const int* in_sizes, int n_in, void* d_out, int out_size, void* d_ws, size_t ws_size, hipStream_t stream) {
    static int grid = 0;
    if (grid == 0) {
        if (n_in != 25 || out_size != SEQ * DM || ws_size < WS_END) { fprintf(stderr, "kernel_launch: unexpected problem (n_in %d, out %d, ws %zu < %zu)\n", n_in, out_size, ws_size, (size_t)WS_END); grid = -1; return; }
        int dev = 0, cus = 0, per_cu = 0;
        if (hipGetDevice(&dev) != hipSuccess || hipDeviceGetAttribute(&cus, hipDeviceAttributeMultiprocessorCount, dev) != hipSuccess) { grid = -1; return; }
        if (hipFuncSetAttribute((const void*)mk_fwd, hipFuncAttributeMaxDynamicSharedMemorySize, LDS_BYTES) != hipSuccess) { fprintf(stderr, "kernel_launch: hipFuncSetAttribute failed\n"); grid = -1; return; }
        if (hipOccupancyMaxActiveBlocksPerMultiprocessor(&per_cu, (const void*)mk_fwd, NWAVES * 64, LDS_BYTES) != hipSuccess || per_cu < 1) fprintf(stderr, "kernel_launch: occupancy query reports %d\n", per_cu);
        (void)hipGetLastError();
        grid = cus;
    }
    if (grid < 0) return;
    if (hipMemsetAsync((char*)d_ws + WS_CTL, 0, CTL_ZERO_BYTES, stream) != hipSuccess) return;
    Args a{};
    for (int i = 0; i < 25; ++i) a.in[i] = (const float*)d_in[i];
    a.out = (float*)d_out; a.ws = (unsigned char*)d_ws;
#if MK_PER_PHASE
    for (int k = 0; k < NPH; ++k) { if (!slot_used(k)) continue; a.ph_lo = k; a.ph_hi = k + 1;
        hipLaunchKernelGGL(mk_fwd, dim3(grid), dim3(NWAVES * 64), LDS_BYTES, stream, a); }
#else
    a.ph_lo = 0; a.ph_hi = NPH;
    hipLaunchKernelGGL(mk_fwd, dim3(grid), dim3(NWAVES * 64), LDS_BYTES, stream, a);
#endif
    const hipError_t le = hipPeekAtLastError();
    if (le != hipSuccess) fprintf(stderr, "kernel_launch: launch failed: %s\n", hipGetErrorName(le));
}
```
